# Optimizing an MI355X kernel written in HIP

```python
import math
import jax, jax.numpy as jnp
from jax import lax
import numpy as np

D_MODEL = 1024
BATCH = 8
SEQ = 4096
DEPTH = 4

N_MIXERS = 2
N_RET_LAYERS = (DEPTH + N_MIXERS - 1) // N_MIXERS
N_NSA_LAYERS = DEPTH // N_MIXERS
NORM_EPS = 1e-6
NEG = -1e30

RET_HEADS = 4
RET_QK_DIM = D_MODEL // RET_HEADS
RET_V_DIM = 2 * D_MODEL // RET_HEADS
RET_CHUNK = 128
RET_ROPE_THETA = 10000.0
RET_IN = 2 * D_MODEL + 2 * (2 * D_MODEL)

NSA_HEADS = 16
NSA_KV_HEADS = 4
NSA_GROUP = NSA_HEADS // NSA_KV_HEADS
NSA_HEAD_DIM = D_MODEL // NSA_HEADS
ROPE_THETA = 500000.0
ROPE_DIM = NSA_HEAD_DIM // 4
CMP_BLOCK = 32
CMP_STRIDE = 16
CMP_HIDDEN = 4 * NSA_HEAD_DIM
SLC_BLOCK = 64
SLC_TOPK = 16
WINDOW = 512
NSA_Q_BLOCK = 32
N_BRANCH = 3
FORCE = 1e4
NSA_QD = NSA_HEADS * NSA_HEAD_DIM
NSA_KVD = NSA_KV_HEADS * NSA_HEAD_DIM
NSA_IN = NSA_QD + N_BRANCH * 2 * NSA_KVD + NSA_HEADS * N_BRANCH

FFN_HIDDEN = ((8 * D_MODEL // 3 + 255) // 256) * 256

kernel_name = "hybrid_retention_nsa_swiglu"


def rms_norm(x, gain):
    xf = x.astype(jnp.float32)
    y = xf * lax.rsqrt(jnp.mean(xf * xf, axis=-1, keepdims=True) + NORM_EPS)
    return (y * gain.astype(jnp.float32)).astype(x.dtype)


def apply_rotary(x, positions, rot_dim, theta):
    half = rot_dim // 2
    inv_freq = theta ** (-2.0 * jnp.arange(half, dtype=jnp.float32) / rot_dim)
    ang = positions.astype(jnp.float32)[..., None] * inv_freq
    cos = jnp.cos(ang)[:, :, None, :]
    sin = jnp.sin(ang)[:, :, None, :]
    xr = x[..., :rot_dim].astype(jnp.float32)
    x1, x2 = xr[..., :half], xr[..., half:]
    rot = jnp.concatenate([x1 * cos - x2 * sin, x2 * cos + x1 * sin], axis=-1).astype(x.dtype)
    return jnp.concatenate([rot, x[..., rot_dim:]], axis=-1)


def chunkwise_retention(q, k, v):
    B, T, H, dk = q.shape
    dv = v.shape[-1]
    C = RET_CHUNK
    N = T // C
    log_g = jnp.log(1.0 - 2.0 ** (-5.0 - jnp.arange(H, dtype=jnp.float32)))
    idx = jnp.arange(C, dtype=jnp.float32)
    diff = idx[:, None] - idx[None, :]
    intra = jnp.where(diff >= 0, jnp.exp(log_g[:, None, None] * jnp.maximum(diff, 0.0)), 0.0)
    q_decay = jnp.exp(log_g[:, None] * (idx + 1.0))[None, :, :, None]
    k_decay = jnp.exp(log_g[:, None] * (C - 1.0 - idx))[None, :, :, None]
    chunk_decay = jnp.exp(log_g * C)[None, :, None, None]

    def to_chunks(a):
        return a.astype(jnp.float32).reshape(B, N, C, H, a.shape[-1]).transpose(1, 0, 3, 2, 4)

    def step(state, inp):
        qc, kc, vc = inp
        s = jnp.einsum('bhid,bhjd->bhij', qc, kc) * intra
        o = (jnp.einsum('bhij,bhje->bhie', s, vc)
             + jnp.einsum('bhid,bhde->bhie', qc * q_decay, state))
        state = state * chunk_decay + jnp.einsum('bhjd,bhje->bhde', kc * k_decay, vc)
        return state, o

    state0 = jnp.zeros((B, H, dk, dv), jnp.float32)
    _, o = lax.scan(step, state0, (to_chunks(q), to_chunks(k), to_chunks(v)))
    return o.transpose(1, 0, 3, 2, 4).reshape(B, T, H, dv)


def retention_mixer(h, positions, w_in, w_out):
    B, T, _ = h.shape
    proj = h @ w_in
    q, k, v, g = jnp.split(proj, [D_MODEL, 2 * D_MODEL, 4 * D_MODEL], axis=-1)
    q = q.reshape(B, T, RET_HEADS, RET_QK_DIM)
    k = k.reshape(B, T, RET_HEADS, RET_QK_DIM) * (RET_QK_DIM ** -0.5)
    v = v.reshape(B, T, RET_HEADS, RET_V_DIM)
    q = apply_rotary(q, positions, RET_QK_DIM, RET_ROPE_THETA)
    k = apply_rotary(k, positions, RET_QK_DIM, RET_ROPE_THETA)
    o = chunkwise_retention(q, k, v)
    o = o * lax.rsqrt(jnp.mean(o * o, axis=-1, keepdims=True) + NORM_EPS)
    o = o.astype(h.dtype).reshape(B, T, 2 * D_MODEL) * jax.nn.silu(g)
    return o @ w_out


def nsa_mixer(h, positions, w_in, cmp_pos, cmp_w1, cmp_w2, w_out):
    B, T, _ = h.shape
    G, HG, HD = NSA_KV_HEADS, NSA_GROUP, NSA_HEAD_DIM
    scale = HD ** -0.5
    proj = h @ w_in
    q = proj[..., :NSA_QD].reshape(B, T, NSA_HEADS, HD)
    kv = proj[..., NSA_QD:NSA_QD + N_BRANCH * 2 * NSA_KVD].reshape(B, T, N_BRANCH, 2, G, HD)
    gates = jax.nn.sigmoid(proj[..., NSA_QD + N_BRANCH * 2 * NSA_KVD:].astype(jnp.float32))
    gates = gates.astype(h.dtype).reshape(B, T, NSA_HEADS, N_BRANCH)

    q = apply_rotary(q, positions, ROPE_DIM, ROPE_THETA)
    k_cmp_tok = apply_rotary(kv[:, :, 0, 0], positions, ROPE_DIM, ROPE_THETA)
    v_cmp_tok = kv[:, :, 0, 1]
    k_slc = apply_rotary(kv[:, :, 1, 0], positions, ROPE_DIM, ROPE_THETA)
    v_slc = kv[:, :, 1, 1]
    k_win = apply_rotary(kv[:, :, 2, 0], positions, ROPE_DIM, ROPE_THETA)
    v_win = kv[:, :, 2, 1]

    n_cmp = (T - CMP_BLOCK) // CMP_STRIDE + 1
    tok_idx = jnp.arange(n_cmp)[:, None] * CMP_STRIDE + jnp.arange(CMP_BLOCK)[None, :]

    def compress(a, pos_emb, w1, w2):
        blocks = a[:, tok_idx] + pos_emb[None, None, :, None, :]
        blocks = blocks.transpose(0, 1, 3, 2, 4).reshape(B, n_cmp, G, CMP_BLOCK * HD)
        return jax.nn.silu(blocks @ w1) @ w2

    k_cmp = compress(k_cmp_tok, cmp_pos[0], cmp_w1[0], cmp_w2[0])
    v_cmp = compress(v_cmp_tok, cmp_pos[1], cmp_w1[1], cmp_w2[1])
    cmp_end = jnp.arange(n_cmp) * CMP_STRIDE + CMP_BLOCK - 1

    NB = T // SLC_BLOCK
    n_sel = min(SLC_TOPK, NB)
    cmp_start = jnp.arange(n_cmp) * CMP_STRIDE
    slc_start = jnp.arange(NB) * SLC_BLOCK
    overlap = ((cmp_start[:, None] < slc_start[None, :] + SLC_BLOCK)
               & (cmp_start[:, None] + CMP_BLOCK > slc_start[None, :])).astype(jnp.float32)
    k_blocks = k_slc.reshape(B, NB, SLC_BLOCK, G, HD).transpose(0, 3, 1, 2, 4)
    v_blocks = v_slc.reshape(B, NB, SLC_BLOCK, G, HD).transpose(0, 3, 1, 2, 4)
    b_ix = jnp.arange(B)[:, None, None, None]
    g_ix = jnp.arange(G)[None, :, None, None]
    blk = jnp.arange(NB)

    k_win_pad = jnp.pad(k_win, ((0, 0), (WINDOW, 0), (0, 0), (0, 0)))
    v_win_pad = jnp.pad(v_win, ((0, 0), (WINDOW, 0), (0, 0), (0, 0)))
    WL = WINDOW + NSA_Q_BLOCK

    def attend(scores, mask, vals, eq_out):
        p = jax.nn.softmax(jnp.where(mask, scores, NEG), axis=-1)
        return p, jnp.einsum(eq_out, p.astype(vals.dtype), vals, preferred_element_type=jnp.float32)

    def q_block(n):
        q0 = n * NSA_Q_BLOCK
        qb = lax.dynamic_slice_in_dim(q, q0, NSA_Q_BLOCK, axis=1).reshape(B, NSA_Q_BLOCK, G, HG, HD)
        gb = lax.dynamic_slice_in_dim(gates, q0, NSA_Q_BLOCK, axis=1).reshape(B, NSA_Q_BLOCK, G, HG, N_BRANCH)
        t_pos = q0 + jnp.arange(NSA_Q_BLOCK)

        s_c = jnp.einsum('bqghd,bkgd->bghqk', qb, k_cmp, preferred_element_type=jnp.float32) * scale
        valid_c = cmp_end[None, :] <= t_pos[:, None]
        p_c, o_cmp = attend(s_c, valid_c, v_cmp, 'bghqk,bkgd->bqghd')
        p_c = p_c * valid_c
        o_cmp = o_cmp * jnp.any(valid_c, axis=-1)[None, :, None, None, None]

        imp = jnp.einsum('bghqk,kn->bgqn', p_c, overlap)
        cur = t_pos // SLC_BLOCK
        forced = (blk[None, :] == 0) | (blk[None, :] == cur[:, None]) | (blk[None, :] == cur[:, None] - 1)
        future = blk[None, :] > cur[:, None]
        imp = jnp.where(future, NEG, jnp.where(forced, imp + FORCE, imp))
        _, sel = lax.top_k(imp, n_sel)
        ks = k_blocks[b_ix, g_ix, sel].reshape(B, G, NSA_Q_BLOCK, n_sel * SLC_BLOCK, HD)
        vs = v_blocks[b_ix, g_ix, sel].reshape(B, G, NSA_Q_BLOCK, n_sel * SLC_BLOCK, HD)
        tok = (sel[..., None] * SLC_BLOCK + jnp.arange(SLC_BLOCK)).reshape(B, G, NSA_Q_BLOCK, n_sel * SLC_BLOCK)
        tmask = (tok <= t_pos[None, None, :, None])[:, :, None]
        s_s = jnp.einsum('bqghd,bgqkd->bghqk', qb, ks, preferred_element_type=jnp.float32) * scale
        _, o_slc = attend(s_s, tmask, vs, 'bghqk,bgqkd->bqghd')

        kw = lax.dynamic_slice_in_dim(k_win_pad, q0, WL, axis=1)
        vw = lax.dynamic_slice_in_dim(v_win_pad, q0, WL, axis=1)
        kpos = q0 - WINDOW + jnp.arange(WL)
        wmask = ((kpos[None, :] <= t_pos[:, None]) & (kpos[None, :] > t_pos[:, None] - WINDOW)
                 & (kpos[None, :] >= 0))
        s_w = jnp.einsum('bqghd,bkgd->bghqk', qb, kw, preferred_element_type=jnp.float32) * scale
        _, o_win = attend(s_w, wmask, vw, 'bghqk,bkgd->bqghd')

        gf = gb.astype(jnp.float32)
        o = gf[..., 0:1] * o_cmp + gf[..., 1:2] * o_slc + gf[..., 2:3] * o_win
        return o.astype(h.dtype).reshape(B, NSA_Q_BLOCK, NSA_QD)

    out = lax.map(q_block, jnp.arange(T // NSA_Q_BLOCK))
    out = out.transpose(1, 0, 2, 3).reshape(B, T, NSA_QD)
    return out @ w_out


def swiglu(h, w_gu, w_down):
    a, b = jnp.split(h @ w_gu, 2, axis=-1)
    return (jax.nn.silu(a) * b) @ w_down


def setup_inputs(seed: int = 0) -> dict:
    key = jax.random.key(seed)
    ks = jax.random.split(key, 16)
    f32 = jnp.float32

    def nrm(k, shape, fan_in):
        return jax.random.normal(k, shape, f32) * (fan_in ** -0.5)

    x = jax.random.normal(ks[0], (BATCH, SEQ, D_MODEL), f32)
    offs = jax.random.randint(ks[1], (BATCH, 1), 0, 1024, dtype=jnp.int32)
    positions = offs + jnp.arange(SEQ, dtype=jnp.int32)[None, :]
    norm_mix = 1.0 + 0.01 * jax.random.normal(ks[2], (DEPTH, D_MODEL), f32)
    norm_ffn = 1.0 + 0.01 * jax.random.normal(ks[3], (DEPTH, D_MODEL), f32)
    norm_final = 1.0 + 0.01 * jax.random.normal(ks[4], (D_MODEL,), f32)
    ret_w_in = nrm(ks[5], (N_RET_LAYERS, D_MODEL, RET_IN), D_MODEL)
    ret_w_out = nrm(ks[6], (N_RET_LAYERS, 2 * D_MODEL, D_MODEL), 2 * D_MODEL)
    nsa_w_in = nrm(ks[7], (N_NSA_LAYERS, D_MODEL, NSA_IN), D_MODEL)
    nsa_cmp_pos = 0.1 * jax.random.normal(ks[8], (N_NSA_LAYERS, 2, CMP_BLOCK, NSA_HEAD_DIM), f32)
    nsa_cmp_w1 = nrm(ks[9], (N_NSA_LAYERS, 2, CMP_BLOCK * NSA_HEAD_DIM, CMP_HIDDEN), CMP_BLOCK * NSA_HEAD_DIM)
    nsa_cmp_w2 = nrm(ks[10], (N_NSA_LAYERS, 2, CMP_HIDDEN, NSA_HEAD_DIM), CMP_HIDDEN)
    nsa_w_out = nrm(ks[11], (N_NSA_LAYERS, NSA_QD, D_MODEL), NSA_QD)
    ffn_w_gu = nrm(ks[12], (DEPTH, D_MODEL, 2 * FFN_HIDDEN), D_MODEL)
    ffn_w_down = nrm(ks[13], (DEPTH, FFN_HIDDEN, D_MODEL), FFN_HIDDEN)
    return {"x": x, "positions": positions, "norm_mix": norm_mix, "norm_ffn": norm_ffn,
            "norm_final": norm_final, "ret_w_in": ret_w_in, "ret_w_out": ret_w_out,
            "nsa_w_in": nsa_w_in, "nsa_cmp_pos": nsa_cmp_pos, "nsa_cmp_w1": nsa_cmp_w1,
            "nsa_cmp_w2": nsa_cmp_w2, "nsa_w_out": nsa_w_out, "ffn_w_gu": ffn_w_gu,
            "ffn_w_down": ffn_w_down}


def reference(x, positions, norm_mix, norm_ffn, norm_final, ret_w_in, ret_w_out, nsa_w_in,
              nsa_cmp_pos, nsa_cmp_w1, nsa_cmp_w2, nsa_w_out, ffn_w_gu, ffn_w_down):
    for i in range(DEPTH):
        hn = rms_norm(x, norm_mix[i])
        j = i // N_MIXERS
        if i % N_MIXERS == 0:
            x = x + retention_mixer(hn, positions, ret_w_in[j], ret_w_out[j])
        else:
            x = x + nsa_mixer(hn, positions, nsa_w_in[j], nsa_cmp_pos[j], nsa_cmp_w1[j],
                              nsa_cmp_w2[j], nsa_w_out[j])
        x = x + swiglu(rms_norm(x, norm_ffn[i]), ffn_w_gu[i], ffn_w_down[i])
    return rms_norm(x, norm_final)
```

```cpp
#ifndef PROBE_DUP
#define PROBE_DUP 0
#endif
#include <hip/hip_runtime.h>
#include <hip/hip_cooperative_groups.h>
#include <cstdio>
namespace cg = cooperative_groups;

#define LAS __attribute__((address_space(3)))
typedef unsigned short bf16_t;
typedef short bf16x8 __attribute__((ext_vector_type(8)));
typedef short bf16x4 __attribute__((ext_vector_type(4)));
typedef float f32x4 __attribute__((ext_vector_type(4)));
typedef unsigned u32x4 __attribute__((ext_vector_type(4)));
typedef unsigned u32x2 __attribute__((ext_vector_type(2)));

constexpr int MT = 32768, SEQ = 4096;
constexpr size_t MiB = 1024 * 1024;
constexpr int LDS_BYTES = 147456;
constexpr size_t WS_WMIX = 0;
constexpr size_t WS_WFFN = 16 * MiB;
constexpr size_t WS_HN = 33 * MiB;
constexpr size_t WS_R = 97 * MiB;
constexpr size_t WS_SSQ = 481 * MiB;
constexpr size_t R_Q = 0, R_K = 64 * MiB, R_V = 128 * MiB, R_G = 256 * MiB;
constexpr size_t N_Q = 0, N_KV = 64 * MiB, N_GATES = 160 * MiB, N_HID = 168 * MiB, N_KC = 176 * MiB, N_ATT = 180 * MiB;

struct Params {
  const float* x; const int* pos; const float* norm_mix; const float* norm_ffn; const float* norm_final;
  const float* ret_w_in; const float* ret_w_out; const float* nsa_w_in; const float* cmp_pos; const float* cmp_w1;
  const float* cmp_w2; const float* nsa_w_out; const float* ffn_w_gu; const float* ffn_w_down;
  float* out; unsigned char* ws;
};

typedef const __attribute__((address_space(4))) Params* KParams;
__device__ __forceinline__ KParams get_params() { KParams q = (KParams)__builtin_amdgcn_kernarg_segment_ptr(); asm volatile("" : "+s"(q)); return q; }
typedef __bf16 bf16x2_t __attribute__((ext_vector_type(2)));
__device__ __forceinline__ unsigned cvt_pk_bf16(float lo, float hi) { bf16x2_t v; v[0] = (__bf16)lo; v[1] = (__bf16)hi; return __builtin_bit_cast(unsigned, v); }
__device__ __forceinline__ float bf2f(unsigned short h) { return __uint_as_float(((unsigned)h) << 16); }
__device__ __forceinline__ float silu_f(float x) { return x * __builtin_amdgcn_rcpf(1.0f + __expf(-x)); }
__device__ __forceinline__ float sigmoid_f(float x) { return __builtin_amdgcn_rcpf(1.0f + __expf(-x)); }
__device__ __forceinline__ bf16x8 tr_read8(LAS unsigned char* a0, LAS unsigned char* a1) {
  bf16x4 lo = __builtin_amdgcn_ds_read_tr16_b64_v4i16((LAS bf16x4*)a0);
  bf16x4 hi = __builtin_amdgcn_ds_read_tr16_b64_v4i16((LAS bf16x4*)a1);
  return __builtin_shufflevector(lo, hi, 0, 1, 2, 3, 4, 5, 6, 7);
}
#define MFMA16(a, b, c) __builtin_amdgcn_mfma_f32_16x16x32_bf16((a), (b), (c), 0, 0, 0)

namespace pg8 {
constexpr int BM = 256, BK = 64, HALF = 128, HTB = HALF * BK * 2, NXCD = 8, WGM = 8;
__device__ __forceinline__ int lds_byte(int r, int c) { const int st = (r >> 4) * 2 + (c >> 5), rr = r & 15, cc = c & 31, ob = rr * 64 + cc * 2; return st * 1024 + (ob ^ (((ob >> 9) & 1) << 5)); }
__device__ __forceinline__ void stage_rc(int b, int& R, int& C) { const int st = b / 1024, sb = b % 1024, swz = sb ^ (((sb >> 9) & 1) << 5); R = (st >> 1) * 16 + swz / 64; C = (st & 1) * 32 + (swz % 64) / 2; }
__device__ __forceinline__ int perm32(int rho) { const int n = rho >> 4, i = rho & 15; return 8 * (i >> 2) + 4 * n + (i & 3); }
struct Unit { int pm, pn; };
struct GemmD { const bf16_t* A; const bf16_t* Bt; int K; int amode; int nM, nN; int smode; };
enum { EK_RES = 0, EK_RETIN = 1, EK_NSAIN = 2, EK_SWIGLU = 3, EK_CMP1 = 4 };
struct EpiD { int kind; int layer; };
struct EpiP { int kind; float* of; const float* base; bf16_t* o0; bf16_t* o1; bf16_t* o2; bf16_t* o3; float* gates; const int* pos; const float* bias; };

__device__ __forceinline__ bool unit_next(const GemmD& g, int i, int G, int c, Unit& u) {
  const long L = (long)i * G + c; const int nwg = g.nM * g.nN; if (L >= nwg) return false;
  if (g.smode == 1) { u.pm = (int)L; u.pn = (int)(L >> 5); return true; }
  int wgid = (int)L; { const int q = nwg / NXCD, r = nwg % NXCD, xcd = wgid % NXCD, off = wgid / NXCD; wgid = (xcd < r ? xcd * (q + 1) : r * (q + 1) + (xcd - r) * q) + off; }
  const int nig = WGM * g.nN, gid = wgid / nig, fm = gid * WGM, gsz = (g.nM - fm) < WGM ? (g.nM - fm) : WGM;
  u.pm = fm + ((wgid % nig) % gsz); u.pn = (wgid % nig) / gsz; return true;
}

__device__ __forceinline__ void store8(bf16_t* p, const f32x4 a, const f32x4 b) {
  u32x4 w; w.x = cvt_pk_bf16(a[0], a[1]); w.y = cvt_pk_bf16(a[2], a[3]); w.z = cvt_pk_bf16(b[0], b[1]); w.w = cvt_pk_bf16(b[2], b[3]); *(u32x4*)p = w;
}

__device__ __forceinline__ void epilogue(const EpiD& ED, f32x4 (&acc)[2][2][4][2], const Unit& u, int wr, int wc, int fr, int fq) {
  asm volatile("" : "+v"(fr), "+v"(fq));
  asm volatile("" : "+s"(wr), "+s"(wc));
  EpiP E;
  { KParams kp = get_params(); unsigned char* ws = kp->ws; unsigned char* R = ws + WS_R; float* outp = kp->out;
    E.kind = ED.kind; E.of = outp; E.base = (ED.layer < 0) ? kp->x : outp; E.pos = kp->pos;
    E.o0 = (bf16_t*)R; E.o1 = (bf16_t*)(R + 64 * MiB); E.o2 = (bf16_t*)(R + R_V); E.o3 = (bf16_t*)(R + R_G); E.gates = (float*)(R + N_GATES); E.bias = (const float*)(ws + WS_WMIX + 10 * MiB + 65536);
    if (ED.kind == EK_CMP1) E.o0 = (bf16_t*)(R + N_HID); }
  const int row0 = u.pm * BM + wr * 64 + fr;
  if (E.kind == EK_RES) {
    const int col0 = u.pn * BM + wc * 32 + 4 * fq;
#pragma unroll
    for (int ai = 0; ai < 2; ++ai) {
      f32x4 bs[4][2][2];
#pragma unroll
      for (int m = 0; m < 4; ++m) { const size_t off = (size_t)(row0 + ai * HALF + m * 16) * 1024 + col0;
#pragma unroll
        for (int bj = 0; bj < 2; ++bj)
#pragma unroll
          for (int n = 0; n < 2; ++n) bs[m][bj][n] = *(const f32x4*)(E.base + off + bj * HALF + n * 16); }
      asm volatile("" ::: "memory");
#pragma unroll
      for (int m = 0; m < 4; ++m) { const size_t off = (size_t)(row0 + ai * HALF + m * 16) * 1024 + col0;
#pragma unroll
        for (int bj = 0; bj < 2; ++bj)
#pragma unroll
          for (int n = 0; n < 2; ++n) *(f32x4*)(E.of + off + bj * HALF + n * 16) = bs[m][bj][n] + acc[ai][bj][m][n]; }
    }
  } else if (E.kind == EK_SWIGLU) {
    const int col0 = u.pn * 128 + wc * 32 + 8 * fq;
#pragma unroll
    for (int ai = 0; ai < 2; ++ai)
#pragma unroll
      for (int m = 0; m < 4; ++m) {
        f32x4 h0, h1;
#pragma unroll
        for (int j = 0; j < 4; ++j) { h0[j] = silu_f(acc[ai][0][m][0][j]) * acc[ai][1][m][0][j]; h1[j] = silu_f(acc[ai][0][m][1][j]) * acc[ai][1][m][1][j]; }
        store8(E.o0 + (size_t)(row0 + ai * HALF + m * 16) * 2816 + col0, h0, h1);
      }
  } else if (E.kind == EK_CMP1) {
    const int which = u.pm >> 5;
#pragma unroll
    for (int bj = 0; bj < 2; ++bj) {
      const int c0 = bj * HALF + wc * 32 + 8 * fq;
      const f32x4 b0 = *(const f32x4*)(E.bias + which * 256 + c0), b1 = *(const f32x4*)(E.bias + which * 256 + c0 + 4);
#pragma unroll
      for (int ai = 0; ai < 2; ++ai)
#pragma unroll
        for (int m = 0; m < 4; ++m) {
          f32x4 h0, h1;
#pragma unroll
          for (int j = 0; j < 4; ++j) { h0[j] = silu_f(acc[ai][bj][m][0][j] + b0[j]); h1[j] = silu_f(acc[ai][bj][m][1][j] + b1[j]); }
          store8(E.o0 + (size_t)(row0 + ai * HALF + m * 16) * 256 + c0, h0, h1);
        }
    }
  } else if (E.kind == EK_RETIN) {
    const int pn = u.pn;
    if (pn < 8) {
      bf16_t* dst = (pn < 4) ? (E.o0 + pn * 256) : (E.o1 + (pn - 4) * 256);
      const float scale = (pn < 4) ? 1.0f : 0.0625f;
      float frq[2][4];
#pragma unroll
      for (int n = 0; n < 2; ++n)
#pragma unroll
        for (int j = 0; j < 4; ++j) { const int jj = 32 * wc + 8 * fq + 4 * n + j; frq[n][j] = exp2f(-(float)jj * (13.287712379549449f / 128.0f)) * 0.15915494309189535f; }
      float pfv[2][4];
#pragma unroll
      for (int ai = 0; ai < 2; ++ai)
#pragma unroll
        for (int m = 0; m < 4; ++m) pfv[ai][m] = (float)E.pos[row0 + ai * HALF + m * 16];
#pragma unroll
      for (int ai = 0; ai < 2; ++ai)
#pragma unroll
        for (int m = 0; m < 4; ++m) {
          const int row = row0 + ai * HALF + m * 16; const float pf = pfv[ai][m];
          f32x4 r1[2], r2[2];
#pragma unroll
          for (int n = 0; n < 2; ++n)
#pragma unroll
            for (int j = 0; j < 4; ++j) {
              float xx = pf * frq[n][j]; xx = xx - floorf(xx);
              const float s = __builtin_amdgcn_sinf(xx), c = __builtin_amdgcn_cosf(xx);
              const float x1 = acc[ai][0][m][n][j] * scale, x2 = acc[ai][1][m][n][j] * scale;
              r1[n][j] = x1 * c - x2 * s; r2[n][j] = x2 * c + x1 * s;
            }
          bf16_t* rp = dst + (size_t)row * 1024 + wc * 32 + 8 * fq;
          store8(rp, r1[0], r1[1]); store8(rp + 128, r2[0], r2[1]);
        }
    } else {
      bf16_t* dst = (pn < 16) ? (E.o2 + (pn - 8) * 256) : (E.o3 + (pn - 16) * 256);
#pragma unroll
      for (int ai = 0; ai < 2; ++ai)
#pragma unroll
        for (int m = 0; m < 4; ++m) {
          bf16_t* rp = dst + (size_t)(row0 + ai * HALF + m * 16) * 2048 + wc * 32 + 8 * fq;
          store8(rp, acc[ai][0][m][0], acc[ai][0][m][1]); store8(rp + 128, acc[ai][1][m][0], acc[ai][1][m][1]);
        }
    }
  } else {
    const int pn = u.pn;
    if (pn < 10) {
      const bool rot = (pn < 4) || (((pn - 4) & 1) == 0);
      bf16_t* dst; int ldo;
      if (pn < 4) { dst = E.o0 + pn * 256; ldo = 1024; } else { dst = E.o1 + (size_t)(pn - 4) * ((size_t)MT * 256); ldo = 256; }
      float frq[2][4];
#pragma unroll
      for (int n = 0; n < 2; ++n)
#pragma unroll
        for (int j = 0; j < 4; ++j) frq[n][j] = exp2f(-(float)(4 * n + j) * (18.931568569324174f / 8.0f)) * 0.15915494309189535f;
      float pfv[2][4];
#pragma unroll
      for (int ai = 0; ai < 2; ++ai)
#pragma unroll
        for (int m = 0; m < 4; ++m) pfv[ai][m] = (float)E.pos[row0 + ai * HALF + m * 16];
#pragma unroll
      for (int ai = 0; ai < 2; ++ai)
#pragma unroll
        for (int m = 0; m < 4; ++m) {
          const int row = row0 + ai * HALF + m * 16; const float pf = pfv[ai][m];
#pragma unroll
          for (int bj = 0; bj < 2; ++bj) {
            f32x4 v0 = acc[ai][bj][m][0], v1 = acc[ai][bj][m][1];
            if (rot && ((wc & 1) == 0)) {
#pragma unroll
              for (int n = 0; n < 2; ++n)
#pragma unroll
                for (int j = 0; j < 4; ++j) {
                  float xx = pf * frq[n][j]; xx = xx - floorf(xx);
                  const float s = __builtin_amdgcn_sinf(xx), c = __builtin_amdgcn_cosf(xx);
                  const float own = (n == 0) ? v0[j] : v1[j];
                  const float oth = __shfl_xor(own, 16);
                  const float res = (fq == 0) ? (own * c - oth * s) : ((fq == 1) ? (own * c + oth * s) : own);
                  if (n == 0) v0[j] = res; else v1[j] = res;
                }
            }
            store8(dst + (size_t)row * ldo + bj * HALF + wc * 32 + 8 * fq, v0, v1);
          }
        }
    } else {
      if (wc < 2) {
#pragma unroll
        for (int ai = 0; ai < 2; ++ai)
#pragma unroll
          for (int m = 0; m < 4; ++m) {
            const int row = row0 + ai * HALF + m * 16;
#pragma unroll
            for (int n = 0; n < 2; ++n) {
              const int c = wc * 32 + 8 * fq + 4 * n;
              if (c < 48) { const f32x4 v = acc[ai][0][m][n]; f32x4 o; o[0] = sigmoid_f(v[0]); o[1] = sigmoid_f(v[1]); o[2] = sigmoid_f(v[2]); o[3] = sigmoid_f(v[3]); *(f32x4*)(E.gates + (size_t)row * 48 + c) = o; }
            }
          }
      }
    }
  }
}

__device__ __forceinline__ void gemm_phase(LAS unsigned char* lds, const GemmD g, const EpiD E, const int G, const int cid) {
  int tid_ = threadIdx.x; asm volatile("" : "+v"(tid_));
  const int tid = tid_, wid = __builtin_amdgcn_readfirstlane(tid >> 6), lane = tid & 63, wr = wid >> 2, wc = wid & 3, fr = lane & 15, fq = lane >> 4;
  const int K = g.K, nt = K / BK;
  const bool perm = (E.kind != EK_RES);
  unsigned voffA[2], voffB[2];
#pragma unroll
  for (int i = 0; i < 2; ++i) { int R, C; stage_rc(tid * 16 + i * 8192, R, C); const int Rb = perm ? ((R & ~31) + perm32(R & 31)) : R;
    voffA[i] = g.amode ? (unsigned)(((R >> 2) * 4096 + (R & 3) * 64) + C) * 2u : (unsigned)(R * K + C) * 2u; voffB[i] = (unsigned)(Rb * K + C) * 2u; }
  const size_t kstepB = (size_t)(BK * 2), hstepB = (size_t)HALF * K * 2, tstepB = 2 * hstepB;
  const size_t kstepA = g.amode ? (size_t)512 : kstepB, hstepA = g.amode ? (size_t)32 * 4096 * 2 : hstepB, tstepA = 2 * hstepA;
  const unsigned ldsw = (unsigned)wid * 1024u;
  const int aoff = lds_byte(wr * 64 + fr, fq * 8), boff = lds_byte(wc * 32 + fr, fq * 8);
#define PG8_SA(b, h) (((b) * 2 + (h)) * HTB)
#define PG8_SB(b, h) ((4 + (b) * 2 + (h)) * HTB)
#define PG8_STAGE(bufoff, gbase, voff) do { _Pragma("unroll") for (int _i = 0; _i < 2; ++_i) \
    __builtin_amdgcn_global_load_lds((const unsigned*)((const char*)(gbase) + (voff)[_i]), (LAS unsigned*)(lds + (bufoff) + ldsw + _i * 8192), 16, 0, 0); } while (0)
#define PG8_LDA(dst, b, h) do { _Pragma("unroll") for (int m = 0; m < 4; ++m) _Pragma("unroll") for (int k = 0; k < 2; ++k) dst[m][k] = *(const LAS bf16x8*)(lds + PG8_SA(b, h) + aoff + m * 2048 + k * 1024); } while (0)
#define PG8_LDB(dst, b, h) do { _Pragma("unroll") for (int n = 0; n < 2; ++n) _Pragma("unroll") for (int k = 0; k < 2; ++k) dst[n][k] = *(const LAS bf16x8*)(lds + PG8_SB(b, h) + boff + n * 2048 + k * 1024); } while (0)
#define PG8_MMA(ai, bj, At, Bt) do { __builtin_amdgcn_s_setprio(1); _Pragma("unroll") for (int m = 0; m < 4; ++m) _Pragma("unroll") for (int n = 0; n < 2; ++n) _Pragma("unroll") for (int k = 0; k < 2; ++k) \
    acc[ai][bj][m][n] = __builtin_amdgcn_mfma_f32_16x16x32_bf16(Bt[n][k], At[m][k], acc[ai][bj][m][n], 0, 0, 0); __builtin_amdgcn_s_setprio(0); } while (0)
#define PG8_WAIT_V(n) asm volatile("s_waitcnt vmcnt(" #n ")" ::: "memory")
#define PG8_WAIT_L(n) asm volatile("s_waitcnt lgkmcnt(" #n ")" ::: "memory")
#define PG8_BAR __builtin_amdgcn_s_barrier()
#define PG8_SCHED __builtin_amdgcn_sched_barrier(0)
  Unit cur, nxt; int ui = 0;
  if (!unit_next(g, 0, G, cid, cur)) return;
  f32x4 acc[2][2][4][2];
#pragma unroll
  for (int a = 0; a < 2; ++a)
#pragma unroll
    for (int b = 0; b < 2; ++b)
#pragma unroll
      for (int m = 0; m < 4; ++m)
#pragma unroll
        for (int n = 0; n < 2; ++n) acc[a][b][m][n] = (f32x4){0.f, 0.f, 0.f, 0.f};
  bf16x8 At[4][2], B0[2][2], B1[2][2];
  const char* cA = (const char*)g.A + (size_t)cur.pm * tstepA; const char* cB = (const char*)g.Bt + (size_t)cur.pn * tstepB;
  PG8_STAGE(PG8_SB(0, 0), cB, voffB); PG8_STAGE(PG8_SA(0, 0), cA, voffA); PG8_STAGE(PG8_SB(0, 1), cB + hstepB, voffB); PG8_STAGE(PG8_SA(0, 1), cA + hstepA, voffA);
  if (wr == 1) PG8_BAR;
  PG8_WAIT_V(4); PG8_BAR;
  PG8_STAGE(PG8_SB(1, 0), cB + kstepB, voffB); PG8_STAGE(PG8_SA(1, 0), cA + kstepA, voffA); PG8_STAGE(PG8_SB(1, 1), cB + hstepB + kstepB, voffB);
  PG8_WAIT_V(6); PG8_BAR;
  for (;;) {
    const bool has_next = unit_next(g, ui + 1, G, cid, nxt);
    const char* nA = has_next ? (const char*)g.A + (size_t)nxt.pm * tstepA : cA; const char* nB = has_next ? (const char*)g.Bt + (size_t)nxt.pn * tstepB : cB;
    for (int t = 0; t < nt; t += 2) {
      const bool last = (t == nt - 2);
      const char* a1 = cA + (size_t)(t + 1) * kstepA;
      const char* a2 = last ? nA : cA + (size_t)(t + 2) * kstepA; const char* b2 = last ? nB : cB + (size_t)(t + 2) * kstepB;
      const char* a3 = a2 + kstepA; const char* b3 = b2 + kstepB;
      PG8_LDB(B0, 0, 0); PG8_SCHED; PG8_LDA(At, 0, 0); PG8_STAGE(PG8_SA(1, 1), a1 + hstepA, voffA);
      PG8_WAIT_L(8); PG8_BAR; PG8_WAIT_L(0); PG8_MMA(0, 0, At, B0); PG8_BAR; PG8_SCHED;
      PG8_LDB(B1, 0, 1); PG8_STAGE(PG8_SB(0, 0), b2, voffB);
      PG8_BAR; PG8_WAIT_L(0); PG8_MMA(0, 1, At, B1); PG8_BAR;
      PG8_LDA(At, 0, 1); PG8_STAGE(PG8_SA(0, 0), a2, voffA);
      PG8_BAR; PG8_WAIT_L(0); PG8_MMA(1, 0, At, B0); PG8_BAR; PG8_SCHED;
      PG8_STAGE(PG8_SB(0, 1), b2 + hstepB, voffB);
      PG8_WAIT_V(6); PG8_BAR; PG8_MMA(1, 1, At, B1); PG8_BAR;
      PG8_LDB(B0, 1, 0); PG8_SCHED; PG8_LDA(At, 1, 0); PG8_STAGE(PG8_SA(0, 1), a2 + hstepA, voffA);
      PG8_WAIT_L(8); PG8_BAR; PG8_WAIT_L(0); PG8_MMA(0, 0, At, B0); PG8_BAR; PG8_SCHED;
      PG8_LDB(B1, 1, 1); PG8_STAGE(PG8_SB(1, 0), b3, voffB);
      PG8_BAR; PG8_WAIT_L(0); PG8_MMA(0, 1, At, B1); PG8_BAR;
      PG8_LDA(At, 1, 1); PG8_STAGE(PG8_SA(1, 0), a3, voffA);
      PG8_BAR; PG8_WAIT_L(0); PG8_MMA(1, 0, At, B0); PG8_BAR; PG8_SCHED;
      PG8_STAGE(PG8_SB(1, 1), b3 + hstepB, voffB);
      PG8_WAIT_V(6); PG8_BAR; PG8_MMA(1, 1, At, B1); PG8_BAR;
    }
    epilogue(E, acc, cur, wr, wc, fr, fq);
    if (!has_next) break;
#pragma unroll
    for (int a = 0; a < 2; ++a)
#pragma unroll
      for (int b = 0; b < 2; ++b)
#pragma unroll
        for (int m = 0; m < 4; ++m)
#pragma unroll
          for (int n = 0; n < 2; ++n) acc[a][b][m][n] = (f32x4){0.f, 0.f, 0.f, 0.f};
    cur = nxt; cA = nA; cB = nB; ++ui;
  }
  PG8_WAIT_V(0);
  if (wr == 0) PG8_BAR;
  PG8_BAR;
#undef PG8_SA
#undef PG8_SB
#undef PG8_STAGE
#undef PG8_LDA
#undef PG8_LDB
#undef PG8_MMA
#undef PG8_WAIT_V
#undef PG8_WAIT_L
#undef PG8_BAR
#undef PG8_SCHED
}
}

__device__ __forceinline__ void conv_matrix(LAS float* tile, const float* W, int K, int N, bf16_t* Wt, int Ndst, int mapkind, int rot, int vb = -1, int vg = 0) {
  int tid_ = threadIdx.x; asm volatile("" : "+v"(tid_));
  const int tid = tid_, G = (vb < 0) ? (int)gridDim.x : vg; const int bidx = (vb < 0) ? (int)blockIdx.x : vb;
  const int nK = K >> 6, njobs = nK * (Ndst >> 6);
  for (int job = (bidx + rot) % G; job < njobs; job += G) {
    const int kt = job % nK, dn0 = (job / nK) * 64;
    int sn0, nvalid;
    if (mapkind == 0) { sn0 = dn0; nvalid = N - dn0; nvalid = nvalid < 0 ? 0 : (nvalid > 64 ? 64 : nvalid); }
    else { const int pn = dn0 >> 8, rem = dn0 & 255; sn0 = (rem >> 7) * 2816 + pn * 128 + (rem & 127); nvalid = 64; }
    { const int i = tid >> 3, j8 = (tid & 7) * 8; f32x4 a = {0.f, 0.f, 0.f, 0.f}, b = a;
      if (j8 < nvalid) { const float* s = W + (size_t)(kt * 64 + i) * N + sn0 + j8; a = *(const f32x4*)s; b = *(const f32x4*)(s + 4); }
#pragma unroll
      for (int e = 0; e < 4; ++e) { tile[i * 65 + j8 + e] = a[e]; tile[i * 65 + j8 + 4 + e] = b[e]; } }
    __syncthreads();
    { const int n = tid >> 3, k8 = (tid & 7) * 8; float v[8];
#pragma unroll
      for (int e = 0; e < 8; ++e) v[e] = tile[(k8 + e) * 65 + n];
      u32x4 w; w.x = cvt_pk_bf16(v[0], v[1]); w.y = cvt_pk_bf16(v[2], v[3]); w.z = cvt_pk_bf16(v[4], v[5]); w.w = cvt_pk_bf16(v[6], v[7]);
      *(u32x4*)(Wt + (size_t)(dn0 + n) * K + kt * 64 + k8) = w; }
    __syncthreads();
  }
}

__device__ __forceinline__ void conv_mix(LAS float* tile, int layer) {
  KParams kp = get_params(); unsigned char* ws = kp->ws; const int j = layer >> 1;
  if ((layer & 1) == 0) {
    conv_matrix(tile, kp->ret_w_in + (size_t)j * 1024 * 6144, 1024, 6144, (bf16_t*)(ws + WS_WMIX), 6144, 0, 0);
    conv_matrix(tile, kp->ret_w_out + (size_t)j * 2048 * 1024, 2048, 1024, (bf16_t*)(ws + WS_WMIX + 12 * MiB), 1024, 0, 0);
  } else {
    conv_matrix(tile, kp->nsa_w_in + (size_t)j * 1024 * 2608, 1024, 2608, (bf16_t*)(ws + WS_WMIX), 2816, 0, 0);
    conv_matrix(tile, kp->nsa_w_out + (size_t)j * 1024 * 1024, 1024, 1024, (bf16_t*)(ws + WS_WMIX + 6 * MiB), 1024, 0, 192);
    for (int which = 0; which < 2; ++which) {
      conv_matrix(tile, kp->cmp_w1 + (size_t)(j * 2 + which) * 2048 * 256, 2048, 256, (bf16_t*)(ws + WS_WMIX + 8 * MiB) + (size_t)which * 256 * 2048, 256, 0, 64 + which * 128);
      conv_matrix(tile, kp->cmp_w2 + (size_t)(j * 2 + which) * 256 * 64, 256, 64, (bf16_t*)(ws + WS_WMIX + 10 * MiB) + (size_t)which * 64 * 256, 64, 0, 32 + which * 8);
    }
    const int bw = (int)blockIdx.x - 100;
    if (bw == 0 || bw == 1) {
      int tid_ = threadIdx.x; asm volatile("" : "+v"(tid_)); const int which = bw, tid = tid_, c = tid & 255, half = tid >> 8;
      const float* pos = kp->cmp_pos + (size_t)(j * 2 + which) * 2048; const float* w1 = kp->cmp_w1 + (size_t)(j * 2 + which) * 2048 * 256;
      float s = 0.f;
      for (int k = half * 1024; k < half * 1024 + 1024; ++k) s += pos[k] * w1[(size_t)k * 256 + c];
      tile[tid] = s; __syncthreads();
      if (tid < 256) ((float*)(ws + WS_WMIX + 10 * MiB + 65536))[which * 256 + c] = tile[tid] + tile[tid + 256];
      __syncthreads();
    }
  }
}
__device__ __forceinline__ void conv_ffn(LAS float* tile, int layer, int vb = -1, int vg = 0) {
  KParams kp = get_params();
  conv_matrix(tile, kp->ffn_w_gu + (size_t)layer * 1024 * 5632, 1024, 5632, (bf16_t*)(kp->ws + WS_WFFN), 5632, 1, 0, vb, vg);
  conv_matrix(tile, kp->ffn_w_down + (size_t)layer * 2816 * 1024, 2816, 1024, (bf16_t*)(kp->ws + WS_WFFN + 11 * MiB), 1024, 0, 128, vb, vg);
}

__device__ __forceinline__ void norm_phase(const float* x, const float* gain, bf16_t* hn, float* outf) {
  int tid_ = threadIdx.x; asm volatile("" : "+v"(tid_));
  const int lane = tid_ & 63, wave = tid_ >> 6, nw = gridDim.x * 8;
  f32x4 gv[4];
#pragma unroll
  for (int i = 0; i < 4; ++i) gv[i] = *(const f32x4*)(gain + i * 256 + lane * 4);
  for (int row = blockIdx.x * 8 + wave; row < MT; row += nw) {
    const float* xr = x + (size_t)row * 1024; f32x4 v[4]; float s = 0.f;
#pragma unroll
    for (int i = 0; i < 4; ++i) { v[i] = *(const f32x4*)(xr + i * 256 + lane * 4); s += v[i][0] * v[i][0] + v[i][1] * v[i][1] + v[i][2] * v[i][2] + v[i][3] * v[i][3]; }
#pragma unroll
    for (int o = 32; o >= 1; o >>= 1) s += __shfl_xor(s, o);
    const float rs = rsqrtf(s * (1.0f / 1024.0f) + 1e-6f);
#pragma unroll
    for (int i = 0; i < 4; ++i) {
      const f32x4 y = v[i] * rs * gv[i];
      if (outf) *(f32x4*)(outf + (size_t)row * 1024 + i * 256 + lane * 4) = y;
      else { u32x2 w; w.x = cvt_pk_bf16(y[0], y[1]); w.y = cvt_pk_bf16(y[2], y[3]); *(u32x2*)(hn + (size_t)row * 1024 + i * 256 + lane * 4) = w; }
    }
  }
}

constexpr int SC_QS = 0, SC_KS = 33792, SC_VS = 67584, SC_VD = 76800, SC_PS = 86016, SC_ST = 95232;
__device__ __forceinline__ void scan_phase(LAS unsigned char* lds, const bf16_t* Q, const bf16_t* Kb, bf16_t* V, float* ssq) {
  int tid_ = threadIdx.x; asm volatile("" : "+v"(tid_));
  const int tid = tid_, wave = __builtin_amdgcn_readfirstlane(tid >> 6), lane = tid & 63, fr = lane & 15, fq = lane >> 4;
  const int tq = (lane & 15) >> 2, tp = lane & 3;
  for (int item = blockIdx.x; item < 256; item += gridDim.x) {
    const int ity = (gridDim.x == 256) ? (((item & 7) * 4 + (item >> 6)) * 8 + ((item >> 3) & 7)) : item;
    const int b = ity >> 5, h = (ity >> 3) & 3, es = ity & 7;
    const float l2g = log2f(1.0f - exp2f(-5.0f - (float)h));
    const bf16_t* qb = Q + (size_t)b * SEQ * 1024 + h * 256; const bf16_t* kb = Kb + (size_t)b * SEQ * 1024 + h * 256;
    bf16_t* vb = V + (size_t)b * SEQ * 2048 + h * 512 + es * 64;
    f32x4 st[4][2];
#pragma unroll
    for (int a = 0; a < 4; ++a) { st[a][0] = (f32x4){0.f, 0.f, 0.f, 0.f}; st[a][1] = st[a][0]; }
    for (int i = tid; i < 33792 / 16; i += 512) *(LAS u32x4*)(lds + SC_ST + i * 16) = (u32x4){0u, 0u, 0u, 0u};
    u32x4 rq[4], rk[4], rv;
    const int vrow = tid >> 3, vc16 = tid & 7;
#define SC_LOAD(c) do { _Pragma("unroll") for (int i = 0; i < 4; ++i) { const int pp = tid + 512 * i, row = pp >> 5, c16 = pp & 31; \
      rq[i] = *(const u32x4*)(qb + (size_t)((c) * 64 + row) * 1024 + c16 * 8); rk[i] = *(const u32x4*)(kb + (size_t)((c) * 64 + row) * 1024 + c16 * 8); } \
      rv = *(const u32x4*)(vb + (size_t)((c) * 64 + vrow) * 2048 + vc16 * 8); } while (0)
    SC_LOAD(0);
    const float cdecay = exp2f(l2g * 64.0f);
    for (int c = 0; c < 64; ++c) {
#pragma unroll
      for (int i = 0; i < 4; ++i) { const int pp = tid + 512 * i, row = pp >> 5, c16 = pp & 31;
        *(LAS u32x4*)(lds + SC_QS + row * 528 + c16 * 16) = rq[i]; *(LAS u32x4*)(lds + SC_KS + row * 528 + c16 * 16) = rk[i]; }
      { *(LAS u32x4*)(lds + SC_VS + vrow * 144 + vc16 * 16) = rv;
        const float kd = exp2f(l2g * (float)(63 - vrow)); u32x4 w;
#pragma unroll
        for (int e = 0; e < 4; ++e) { const unsigned u = rv[e]; w[e] = cvt_pk_bf16(__uint_as_float(u << 16) * kd, __uint_as_float(u & 0xffff0000u) * kd); }
        *(LAS u32x4*)(lds + SC_VD + vrow * 144 + vc16 * 16) = w; }
      __syncthreads();
      if (c + 1 < 64) SC_LOAD(c + 1);
      const int rt = wave >> 1, wh = wave & 1;
      bf16x8 qf[8];
#pragma unroll
      for (int ks = 0; ks < 8; ++ks) qf[ks] = *(const LAS bf16x8*)(lds + SC_QS + (16 * rt + fr) * 528 + (32 * ks + 8 * fq) * 2);
#pragma unroll
      for (int cti = 0; cti < 2; ++cti) {
        const int ct = 2 * wh + cti; f32x4 a = {0.f, 0.f, 0.f, 0.f};
        if (ct <= rt) {
#pragma unroll
          for (int ks = 0; ks < 8; ++ks) { const bf16x8 kf = *(const LAS bf16x8*)(lds + SC_KS + (16 * ct + fr) * 528 + (32 * ks + 8 * fq) * 2); a = MFMA16(kf, qf[ks], a); }
        }
        { const int i = 16 * rt + fr, j0 = 16 * ct + 4 * fq; float pv[4];
#pragma unroll
          for (int r = 0; r < 4; ++r) pv[r] = (i >= j0 + r) ? a[r] * exp2f(l2g * (float)(i - j0 - r)) : 0.f;
          u32x2 w; w.x = cvt_pk_bf16(pv[0], pv[1]); w.y = cvt_pk_bf16(pv[2], pv[3]);
          *(LAS u32x2*)(lds + SC_PS + i * 144 + j0 * 2) = w; }
      }
      __syncthreads();
      {
        const int ti = 16 * rt + fr;
        const float qd = exp2f(l2g * (float)(ti + 1));
        bf16x8 pf[2];
#pragma unroll
        for (int ks = 0; ks < 2; ++ks) pf[ks] = *(const LAS bf16x8*)(lds + SC_PS + ti * 144 + (32 * ks + 8 * fq) * 2);
        float sq = 0.f;
#pragma unroll
        for (int eti = 0; eti < 2; ++eti) {
          const int et = 2 * wh + eti; f32x4 a1 = {0.f, 0.f, 0.f, 0.f}, a2 = a1;
#pragma unroll
          for (int ks = 0; ks < 2; ++ks) {
            LAS unsigned char* va = lds + SC_VS + (32 * ks + 8 * fq + tq) * 144 + (16 * et + 4 * tp) * 2;
            const bf16x8 vf = tr_read8(va, va + 4 * 144);
            a1 = MFMA16(vf, pf[ks], a1);
          }
#pragma unroll
          for (int ks = 0; ks < 8; ++ks) { const bf16x8 sf = *(const LAS bf16x8*)(lds + SC_ST + (16 * et + fr) * 528 + (32 * ks + 8 * fq) * 2); a2 = MFMA16(sf, qf[ks], a2); }
          const f32x4 o = a1 + a2 * qd;
          sq += o[0] * o[0] + o[1] * o[1] + o[2] * o[2] + o[3] * o[3];
          u32x2 w; w.x = cvt_pk_bf16(o[0], o[1]); w.y = cvt_pk_bf16(o[2], o[3]);
          *(u32x2*)(vb + (size_t)(c * 64 + ti) * 2048 + 16 * et + 4 * fq) = w;
        }
        sq += __shfl_xor(sq, 16); sq += __shfl_xor(sq, 32);
        if (fq == 0) ssq[((size_t)(b * SEQ + c * 64 + ti) * 4 + h) * 16 + es * 2 + wh] = sq;
      }
      {
        bf16x8 kf[2][2];
#pragma unroll
        for (int dtl = 0; dtl < 2; ++dtl)
#pragma unroll
          for (int ks = 0; ks < 2; ++ks) { LAS unsigned char* ka = lds + SC_KS + (32 * ks + 8 * fq + tq) * 528 + (32 * wave + 16 * dtl + 4 * tp) * 2; kf[dtl][ks] = tr_read8(ka, ka + 4 * 528); }
#pragma unroll
        for (int et = 0; et < 4; ++et) {
          bf16x8 vf[2];
#pragma unroll
          for (int ks = 0; ks < 2; ++ks) { LAS unsigned char* va = lds + SC_VD + (32 * ks + 8 * fq + tq) * 144 + (16 * et + 4 * tp) * 2; vf[ks] = tr_read8(va, va + 4 * 144); }
#pragma unroll
          for (int dtl = 0; dtl < 2; ++dtl) { f32x4 a = st[et][dtl] * cdecay;
#pragma unroll
            for (int ks = 0; ks < 2; ++ks) a = MFMA16(kf[dtl][ks], vf[ks], a);
            st[et][dtl] = a; }
        }
      }
      __syncthreads();
#pragma unroll
      for (int et = 0; et < 4; ++et)
#pragma unroll
        for (int dtl = 0; dtl < 2; ++dtl)
          { u32x2 w; w.x = cvt_pk_bf16(st[et][dtl][0], st[et][dtl][1]); w.y = cvt_pk_bf16(st[et][dtl][2], st[et][dtl][3]);
            *(LAS u32x2*)(lds + SC_ST + (16 * et + fr) * 528 + (32 * wave + 16 * dtl + 4 * fq) * 2) = w; }
    }
    __syncthreads();
#undef SC_LOAD
  }
}

__device__ __forceinline__ void gate_phase(bf16_t* V, const bf16_t* Gt, const float* ssq) {
  int tid_ = threadIdx.x; asm volatile("" : "+v"(tid_));
  const int lane = tid_ & 63, wave = tid_ >> 6, nw = gridDim.x * 8;
  for (int u = blockIdx.x * 8 + wave; u < MT * 4; u += nw) {
    float s = (lane < 16) ? ssq[(size_t)u * 16 + lane] : 0.f;
    s += __shfl_xor(s, 1); s += __shfl_xor(s, 2); s += __shfl_xor(s, 4); s += __shfl_xor(s, 8);
    s = __shfl(s, 0);
    const float rs = rsqrtf(s * (1.0f / 512.0f) + 1e-6f);
    const size_t off = (size_t)u * 512 + lane * 8;
    const u32x4 o = *(const u32x4*)(V + off), g = *(const u32x4*)(Gt + off); u32x4 w;
#pragma unroll
    for (int e = 0; e < 4; ++e) {
      const float o0 = __uint_as_float(o[e] << 16), o1 = __uint_as_float(o[e] & 0xffff0000u), g0 = __uint_as_float(g[e] << 16), g1 = __uint_as_float(g[e] & 0xffff0000u);
      w[e] = cvt_pk_bf16(o0 * rs * silu_f(g0), o1 * rs * silu_f(g1));
    }
    *(u32x4*)(V + off) = w;
  }
}

__device__ __forceinline__ void cmp2_phase(const bf16_t* hid, const bf16_t* w2t, bf16_t* kc, int it0 = -1) {
  int tid_ = threadIdx.x; asm volatile("" : "+v"(tid_));
  const int lane = tid_ & 63, wave = tid_ >> 6, nw = gridDim.x * 8, fr = lane & 15, fq = lane >> 4;
  for (int it = it0 + wave; it < it0 + 16; it += 8) {
    const int which = it >> 9;
    bf16x8 af[8];
#pragma unroll
    for (int ks = 0; ks < 8; ++ks) af[ks] = *(const bf16x8*)(hid + (size_t)(it * 16 + fr) * 256 + 32 * ks + 8 * fq);
#pragma unroll
    for (int ct = 0; ct < 4; ++ct) {
      f32x4 a = {0.f, 0.f, 0.f, 0.f};
#pragma unroll
      for (int ks = 0; ks < 8; ++ks) { const bf16x8 bf = *(const bf16x8*)(w2t + (size_t)which * 64 * 256 + (size_t)(16 * ct + fr) * 256 + 32 * ks + 8 * fq); a = MFMA16(af[ks], bf, a); }
#pragma unroll
      for (int r = 0; r < 4; ++r) {
        const int rr = (it * 16 + 4 * fq + r) & 8191, b = rr >> 10, n = (rr >> 2) & 255, g = rr & 3;
        const float v = (n == 255) ? 0.f : a[r];
        kc[(size_t)which * (8 * 4 * 256 * 64) + ((size_t)((b * 4 + g) * 256 + n)) * 64 + 16 * ct + fr] = (unsigned short)(cvt_pk_bf16(v, 0.f) & 0xffffu);
      }
    }
  }
}

constexpr int AT_KC = 0, AT_VC = 36864, AT_PS = 73728, AT_VALS = 106496, AT_PARK = 114688;
template <int MM>
__device__ __forceinline__ void flash_block2(LAS unsigned char* kt_, LAS unsigned char* vt_, const bf16x8 (&qf)[2][2], f32x4 (&ot)[2][4], float (&mrun)[2], float (&lrun)[2],
                                             const int fr, const int fq, const int tq, const int tp, const int mode, const int pos0, const int (&t)[2], const unsigned long long (&selmask)[2], const int nblk) {
  f32x4 s[2][4];
  __builtin_amdgcn_s_setprio(1);
#pragma unroll
  for (int kt = 0; kt < 4; ++kt) { f32x4 a0 = {0.f, 0.f, 0.f, 0.f}, a1 = a0;
#pragma unroll
    for (int ks = 0; ks < 2; ++ks) { const bf16x8 kf = *(const LAS bf16x8*)(kt_ + (16 * kt + fr) * 144 + (32 * ks + 8 * fq) * 2); a0 = MFMA16(kf, qf[0][ks], a0); a1 = MFMA16(kf, qf[1][ks], a1); }
    s[0][kt] = a0; s[1][kt] = a1; __builtin_amdgcn_sched_barrier(0); }
  __builtin_amdgcn_s_setprio(0);
#pragma unroll
  for (int rg = 0; rg < 2; ++rg) {
    const bool rowsel = (mode == 0) ? ((selmask[rg] >> nblk) & 1ull) != 0ull : true;
    float mx = -1e30f;
    if (MM == 0) {
#pragma unroll
      for (int kt = 0; kt < 4; ++kt)
#pragma unroll
        for (int r = 0; r < 4; ++r) { const int pos = pos0 + 16 * kt + 4 * fq + r; const bool v = rowsel && (pos <= t[rg]) && (mode == 0 || pos > t[rg] - 512);
          const float sv = v ? s[rg][kt][r] : -1e30f; s[rg][kt][r] = sv; mx = fmaxf(mx, sv); }
    } else {
#pragma unroll
      for (int kt = 0; kt < 4; ++kt) mx = fmaxf(fmaxf(mx, fmaxf(s[rg][kt][0], s[rg][kt][1])), fmaxf(s[rg][kt][2], s[rg][kt][3]));
      if (MM == 1 && !rowsel) mx = -1e30f;
    }
    mx = fmaxf(mx, __shfl_xor(mx, 16)); mx = fmaxf(mx, __shfl_xor(mx, 32));
    const float mnew = fmaxf(mrun[rg], mx); const bool moved = mnew != mrun[rg];
    const float msub = (MM == 1 && !rowsel) ? 1e30f : mnew;
    float ls = 0.f;
#pragma unroll
    for (int kt = 0; kt < 4; ++kt)
#pragma unroll
      for (int r = 0; r < 4; ++r) { float pv = __builtin_amdgcn_exp2f(s[rg][kt][r] - msub);
        if (MM == 0) pv = (s[rg][kt][r] > -1e29f) ? pv : 0.f;
        s[rg][kt][r] = pv; ls += pv; }
    if (__ballot(moved) != 0ull) {
      const float alpha = __builtin_amdgcn_exp2f(mrun[rg] - mnew); lrun[rg] *= alpha;
#pragma unroll
      for (int dt = 0; dt < 4; ++dt) ot[rg][dt] *= alpha;
    }
    mrun[rg] = mnew; lrun[rg] += ls;
    __builtin_amdgcn_sched_barrier(0);
  }
  __builtin_amdgcn_s_setprio(1);
#pragma unroll
  for (int kk = 0; kk < 2; ++kk) {
    bf16x8 pf[2];
#pragma unroll
    for (int rg = 0; rg < 2; ++rg) { u32x4 w; w.x = cvt_pk_bf16(s[rg][2 * kk][0], s[rg][2 * kk][1]); w.y = cvt_pk_bf16(s[rg][2 * kk][2], s[rg][2 * kk][3]); w.z = cvt_pk_bf16(s[rg][2 * kk + 1][0], s[rg][2 * kk + 1][1]); w.w = cvt_pk_bf16(s[rg][2 * kk + 1][2], s[rg][2 * kk + 1][3]);
      pf[rg] = __builtin_bit_cast(bf16x8, w); }
#pragma unroll
    for (int dt = 0; dt < 4; ++dt) { LAS unsigned char* va = vt_ + (32 * kk + 4 * fq + tq) * 144 + (16 * dt + 4 * tp) * 2; const bf16x8 vf = tr_read8(va, va + 16 * 144);
      ot[0][dt] = MFMA16(vf, pf[0], ot[0][dt]); ot[1][dt] = MFMA16(vf, pf[1], ot[1][dt]); }
    __builtin_amdgcn_sched_barrier(0);
  }
  __builtin_amdgcn_s_setprio(0);
}

__device__ __forceinline__ void attn_phase(LAS unsigned char* lds, const bf16_t* Qb, const bf16_t* KV, const float* gates, const bf16_t* KC, bf16_t* ATT) {
  int tid_ = threadIdx.x; asm volatile("" : "+v"(tid_));
  const int tid = tid_, wave = __builtin_amdgcn_readfirstlane(tid >> 6), lane = tid & 63, fr = lane & 15, fq = lane >> 4, tq = (lane & 15) >> 2, tp = lane & 3;
  const int G = gridDim.x;
  const int lkey = tid >> 3, lc16 = tid & 7;
  const bool xcd_order = (G == 256);
  for (int it = 0; it < (xcd_order ? 8 : (2048 + G - 1) / G); ++it) {
    int bg, tile;
    if (xcd_order) { const int x = blockIdx.x & 7, slot = blockIdx.x >> 3; bg = 8 * (it >> 1) + x; tile = (it & 1) ? 63 - slot : slot; }
    else { const int id = it * G + (int)blockIdx.x; if (id >= 2048) break; bg = id >> 6; tile = ((id & 63) + 8 * (id >> 8)) & 63; }
    const int b = bg >> 2, g = bg & 3, q0 = tile * 64, cur = tile;
    const int head = fr & 3;
    int t[2]; size_t grow[2]; bf16x8 qf[2][2]; float g_cmp[2], g_slc[2], g_win[2];
#pragma unroll
    for (int rg = 0; rg < 2; ++rg) { t[rg] = q0 + 32 * rg + 4 * wave + (fr >> 2); grow[rg] = (size_t)b * SEQ + t[rg];
#pragma unroll
      for (int ks = 0; ks < 2; ++ks) { const u32x4 qraw = *(const u32x4*)(Qb + grow[rg] * 1024 + (g * 4 + head) * 64 + 32 * ks + 8 * fq); u32x4 qs;
#pragma unroll
        for (int e = 0; e < 4; ++e) qs[e] = cvt_pk_bf16(__uint_as_float(qraw[e] << 16) * 0.18033688011112042f, __uint_as_float(qraw[e] & 0xffff0000u) * 0.18033688011112042f);
        qf[rg][ks] = __builtin_bit_cast(bf16x8, qs); }
      const float* gp = gates + grow[rg] * 48 + (g * 4 + head) * 3; g_cmp[rg] = gp[0]; g_slc[rg] = gp[1]; g_win[rg] = gp[2]; }
    const int kbmax = ((q0 + 32) >> 10) < 3 ? ((q0 + 32) >> 10) : 3;
    { const bf16_t* kc = KC + (size_t)(b * 4 + g) * 256 * 64; const bf16_t* vc = kc + (size_t)8 * 4 * 256 * 64;
#pragma unroll
      for (int i = 0; i < 4; ++i) { const int pp = tid + 512 * i, key = pp >> 3, c16 = pp & 7;
        *(LAS u32x4*)(lds + AT_KC + key * 144 + c16 * 16) = *(const u32x4*)(kc + key * 64 + c16 * 8);
        *(LAS u32x4*)(lds + AT_VC + key * 144 + c16 * 16) = *(const u32x4*)(vc + key * 64 + c16 * 8); } }
    if (kbmax < 3) {
#pragma unroll
      for (int i = 0; i < 4; ++i) *(LAS u32x4*)(lds + AT_PS + (tid + 512 * i) * 16) = (u32x4){0u, 0u, 0u, 0u};
    }
    __syncthreads();
    unsigned long long selmask[2];
#pragma unroll
    for (int rg = 0; rg < 2; ++rg) {
      const int tokl = 4 * wave + (fr >> 2), tt = t[rg];
      float mx = -1e30f, ls = 0.f;
#pragma unroll 1
      for (int kb = 0; kb <= kbmax; ++kb) {
        float bm = -1e30f; f32x4 s[4];
#pragma unroll
        for (int kt = 0; kt < 4; ++kt) { f32x4 a = {0.f, 0.f, 0.f, 0.f};
#pragma unroll
          for (int ks = 0; ks < 2; ++ks) { const bf16x8 kf = *(const LAS bf16x8*)(lds + AT_KC + (64 * kb + 16 * kt + fr) * 144 + (32 * ks + 8 * fq) * 2); a = MFMA16(kf, qf[rg][ks], a); }
#pragma unroll
          for (int r = 0; r < 4; ++r) { const int key = 64 * kb + 16 * kt + 4 * fq + r; const float sv = (16 * key + 31 <= tt) ? a[r] : -1e30f; a[r] = sv; bm = fmaxf(bm, sv); }
          s[kt] = a; }
        bm = fmaxf(bm, __shfl_xor(bm, 16)); bm = fmaxf(bm, __shfl_xor(bm, 32));
        const float mnew = fmaxf(mx, bm); float bs = 0.f;
#pragma unroll
        for (int kt = 0; kt < 4; ++kt)
#pragma unroll
          for (int r = 0; r < 4; ++r) { const int key = 64 * kb + 16 * kt + 4 * fq + r; bs += (16 * key + 31 <= tt) ? __builtin_amdgcn_exp2f(s[kt][r] - mnew) : 0.f; }
        ls = ls * __builtin_amdgcn_exp2f(mx - mnew) + bs; mx = mnew;
      }
      ls += __shfl_xor(ls, 16); ls += __shfl_xor(ls, 32);
      const float inv = (tt >= 31) ? 1.0f / ls : 0.f;
      f32x4 ot[4];
#pragma unroll
      for (int dt = 0; dt < 4; ++dt) ot[dt] = (f32x4){0.f, 0.f, 0.f, 0.f};
#pragma unroll 1
      for (int kb = 0; kb <= kbmax; ++kb) {
        f32x4 s[4];
#pragma unroll
        for (int kt = 0; kt < 4; ++kt) { f32x4 a = {0.f, 0.f, 0.f, 0.f};
#pragma unroll
          for (int ks = 0; ks < 2; ++ks) { const bf16x8 kf = *(const LAS bf16x8*)(lds + AT_KC + (64 * kb + 16 * kt + fr) * 144 + (32 * ks + 8 * fq) * 2); a = MFMA16(kf, qf[rg][ks], a); }
#pragma unroll
          for (int r = 0; r < 4; ++r) { const int key = 64 * kb + 16 * kt + 4 * fq + r; a[r] = (16 * key + 31 <= tt) ? __builtin_amdgcn_exp2f(a[r] - mx) * inv : 0.f; }
          s[kt] = a;
          f32x4 hs = a;
#pragma unroll
          for (int r = 0; r < 4; ++r) { hs[r] += __shfl_xor(hs[r], 1); hs[r] += __shfl_xor(hs[r], 2); }
          if (head == 0) *(LAS f32x4*)(lds + AT_PS + (tokl * 256 + 64 * kb + 16 * kt + 4 * fq) * 4) = hs; }
#pragma unroll
        for (int kk = 0; kk < 2; ++kk) {
          u32x4 w; w.x = cvt_pk_bf16(s[2 * kk][0], s[2 * kk][1]); w.y = cvt_pk_bf16(s[2 * kk][2], s[2 * kk][3]); w.z = cvt_pk_bf16(s[2 * kk + 1][0], s[2 * kk + 1][1]); w.w = cvt_pk_bf16(s[2 * kk + 1][2], s[2 * kk + 1][3]);
          const bf16x8 pf = __builtin_bit_cast(bf16x8, w);
#pragma unroll
          for (int dt = 0; dt < 4; ++dt) { LAS unsigned char* va = lds + AT_VC + (64 * kb + 32 * kk + 4 * fq + tq) * 144 + (16 * dt + 4 * tp) * 2; const bf16x8 vf = tr_read8(va, va + 16 * 144); ot[dt] = MFMA16(vf, pf, ot[dt]); }
        }
      }
#pragma unroll
      for (int dt = 0; dt < 4; ++dt) { const f32x4 o = ot[dt] * g_cmp[rg]; u32x2 w; w.x = cvt_pk_bf16(o[0], o[1]); w.y = cvt_pk_bf16(o[2], o[3]); *(LAS u32x2*)(lds + AT_PARK + tid * 64 + (rg * 4 + dt) * 8) = w; }
      __syncthreads();
      const int tk = lane >> 4;
      float val[4];
#pragma unroll
      for (int i = 0; i < 4; ++i) { const int n = (lane & 15) + 16 * i; float imp = 0.f;
#pragma unroll
        for (int k = -1; k < 4; ++k) { const int key = 4 * n + k; if (key >= 0) imp += *(const LAS float*)(lds + AT_PS + ((4 * wave + tk) * 256 + key) * 4); }
        const bool fut = n > cur, forced = (n == 0) || (n == cur) || (n == cur - 1);
        val[i] = fut ? -1e30f : (forced ? imp + 1e4f : imp);
        *(LAS float*)(lds + AT_VALS + ((4 * wave + tk) * 64 + n) * 4) = val[i]; }
      __syncthreads();
      int rank[4] = {0, 0, 0, 0};
      for (int n2 = 0; n2 < 64; ++n2) { const float v2 = *(const LAS float*)(lds + AT_VALS + ((4 * wave + tk) * 64 + n2) * 4);
#pragma unroll
        for (int i = 0; i < 4; ++i) { const int n = (lane & 15) + 16 * i; rank[i] += (v2 > val[i] || (v2 == val[i] && n2 < n)) ? 1 : 0; } }
      unsigned long long m = 0ull;
#pragma unroll
      for (int i = 0; i < 4; ++i) { const unsigned long long bal = __ballot(rank[i] < 16); m |= ((bal >> (16 * (fr >> 2))) & 0xffffull) << (16 * i); }
      selmask[rg] = m;
      __syncthreads();
    }
#pragma unroll 1
    for (int br = 0; br < 2; ++br) {
      const bf16_t* Kg = KV + (size_t)(br == 0 ? 2 : 4) * ((size_t)MT * 256) + (size_t)b * SEQ * 256 + g * 64; const bf16_t* Vg = Kg + (size_t)MT * 256;
      const int nlo = (br == 0) ? 0 : ((q0 - 511) > 0 ? ((q0 - 511) >> 6) : 0), nhi = cur;
      f32x4 ot[2][4];
#pragma unroll
      for (int rg = 0; rg < 2; ++rg)
#pragma unroll
        for (int dt = 0; dt < 4; ++dt) ot[rg][dt] = (f32x4){0.f, 0.f, 0.f, 0.f};
      float mrun[2] = {-1e30f, -1e30f}, lrun[2] = {0.f, 0.f};
      u32x4 kr[2], vr[2];
#pragma unroll
      for (int u = 0; u < 2; ++u) if (nlo + u <= nhi) { kr[u] = *(const u32x4*)(Kg + (size_t)((nlo + u) * 64 + lkey) * 256 + lc16 * 8); vr[u] = *(const u32x4*)(Vg + (size_t)((nlo + u) * 64 + lkey) * 256 + lc16 * 8); }
      for (int nb = nlo; nb <= nhi; nb += 2) {
        const int sb = ((nb - nlo) >> 1) & 1;
#pragma unroll
        for (int u = 0; u < 2; ++u) if (nb + u <= nhi) { LAS unsigned char* kb_ = lds + (2 * sb + u) * 18432;
          *(LAS u32x4*)(kb_ + lkey * 144 + lc16 * 16) = kr[u]; *(LAS u32x4*)(kb_ + 9216 + lkey * 144 + lc16 * 16) = vr[u]; }
        __syncthreads();
#pragma unroll
        for (int u = 0; u < 2; ++u) if (nb + 2 + u <= nhi) { kr[u] = *(const u32x4*)(Kg + (size_t)((nb + 2 + u) * 64 + lkey) * 256 + lc16 * 8); vr[u] = *(const u32x4*)(Vg + (size_t)((nb + 2 + u) * 64 + lkey) * 256 + lc16 * 8); }
#pragma unroll
        for (int u = 0; u < 2; ++u) {
          const int n = nb + u;
          if (n <= nhi) {
            LAS unsigned char* kb_ = lds + (2 * sb + u) * 18432; LAS unsigned char* vb_ = kb_ + 9216;
            const bool need = (br == 1) || (__ballot((((selmask[0] | selmask[1]) >> n) & 1ull) != 0ull) != 0ull);
            if (need) {
              const bool interior = (br == 0) ? (n < cur) : ((64 * n + 63 <= q0) && (64 * n > q0 + 63 - 512));
              if (!interior) flash_block2<0>(kb_, vb_, qf, ot, mrun, lrun, fr, fq, tq, tp, br, n * 64, t, selmask, n);
              else if (br == 0) flash_block2<1>(kb_, vb_, qf, ot, mrun, lrun, fr, fq, tq, tp, br, n * 64, t, selmask, n);
              else flash_block2<2>(kb_, vb_, qf, ot, mrun, lrun, fr, fq, tq, tp, br, n * 64, t, selmask, n);
            }
          }
        }
      }
      __syncthreads();
#pragma unroll
      for (int rg = 0; rg < 2; ++rg) {
        float lt = lrun[rg]; lt += __shfl_xor(lt, 16); lt += __shfl_xor(lt, 32);
        const float sc_ = (lt > 0.f) ? ((br == 0 ? g_slc[rg] : g_win[rg]) / lt) : 0.f;
#pragma unroll
        for (int dt = 0; dt < 4; ++dt) { const u32x2 p0 = *(const LAS u32x2*)(lds + AT_PARK + tid * 64 + (rg * 4 + dt) * 8); const f32x4 o = ot[rg][dt] * sc_; u32x2 w;
          w.x = cvt_pk_bf16(__uint_as_float(p0.x << 16) + o[0], __uint_as_float(p0.x & 0xffff0000u) + o[1]); w.y = cvt_pk_bf16(__uint_as_float(p0.y << 16) + o[2], __uint_as_float(p0.y & 0xffff0000u) + o[3]);
          if (br == 0) *(LAS u32x2*)(lds + AT_PARK + tid * 64 + (rg * 4 + dt) * 8) = w;
          else *(u32x2*)(ATT + grow[rg] * 1024 + (g * 4 + head) * 64 + 16 * dt + 4 * fq) = w; }
      }
    }
    __syncthreads();
  }
}

constexpr size_t WS_BAR = 490 * MiB;
struct FastBar { unsigned* bar; unsigned xcc, nloc, nx; };
__device__ __forceinline__ unsigned xcc_id() { return (unsigned)__builtin_amdgcn_s_getreg((3 << 11) | 20) & 0xFu; }
__device__ __forceinline__ void fast_barrier(const FastBar& fb, const unsigned target) {
  asm volatile("s_waitcnt vmcnt(0)" ::: "memory");
  __syncthreads();
  if (threadIdx.x == 0) {
    const unsigned old = __hip_atomic_fetch_add(fb.bar + 64 * fb.xcc, 1u, __ATOMIC_RELAXED, __HIP_MEMORY_SCOPE_AGENT);
    if (old + 1u == target * fb.nloc) {
      __builtin_amdgcn_fence(__ATOMIC_RELEASE, "agent");
      const unsigned t = __hip_atomic_fetch_add(fb.bar + 64 * 32, 1u, __ATOMIC_RELAXED, __HIP_MEMORY_SCOPE_AGENT);
      if (t + 1u == target * fb.nx) __hip_atomic_store(fb.bar + 64 * 33, target, __ATOMIC_RELAXED, __HIP_MEMORY_SCOPE_AGENT);
    }
    while (__hip_atomic_load(fb.bar + 64 * 33, __ATOMIC_RELAXED, __HIP_MEMORY_SCOPE_AGENT) < target) __builtin_amdgcn_s_sleep(1);
    __builtin_amdgcn_fence(__ATOMIC_ACQUIRE, "agent");
    asm volatile("s_waitcnt vmcnt(0)" ::: "memory");
  }
  __syncthreads();
}
enum { K_RETIN = 0, K_RETOUT = 1, K_NSAIN = 2, K_CMP1 = 3, K_NSAOUT = 4, K_GU = 5, K_DOWN = 6, K_SCAN = 7, K_GATE = 8, K_CMP2 = 9, K_ATTN = 10, K_NORMFFN = 11, K_NORMNEXT = 12 };

__global__ void __launch_bounds__(512, 2) mega_fwd(Params p_unused) {
  extern __shared__ __attribute__((aligned(16))) unsigned char lds_raw[];
  LAS unsigned char* lds = (LAS unsigned char*)lds_raw;
  cg::grid_group grid = cg::this_grid();
  FastBar fb; fb.bar = (unsigned*)(get_params()->ws + WS_BAR); fb.xcc = xcc_id();
  if (threadIdx.x == 0) __hip_atomic_fetch_add(fb.bar + 64 * (16 + fb.xcc), 1u, __ATOMIC_RELAXED, __HIP_MEMORY_SCOPE_AGENT);
  conv_mix((LAS float*)lds, 0);
  { KParams kp = get_params(); norm_phase(kp->x, kp->norm_mix, (bf16_t*)(kp->ws + WS_HN), nullptr); }
  grid.sync();
  { unsigned nx = 0u, nloc = 0u;
    for (unsigned j = 0; j < 16u; ++j) { const unsigned c = __hip_atomic_load(fb.bar + 64 * (16 + j), __ATOMIC_RELAXED, __HIP_MEMORY_SCOPE_AGENT); nx += (c > 0u) ? 1u : 0u; nloc = (j == fb.xcc) ? c : nloc; }
    fb.nx = (unsigned)__builtin_amdgcn_readfirstlane((int)nx); fb.nloc = (unsigned)__builtin_amdgcn_readfirstlane((int)nloc); }
#pragma unroll 1
  for (int layer = 0; layer < 4; ++layer) {
#pragma unroll 1
    for (int s = 0; s < 9; ++s) {
      const bool nsa = (layer & 1) != 0;
      const unsigned long long prog = nsa ? 0xFC65B4A32ull : 0xFC65B1870ull;
      const int kind = (int)((prog >> (4 * s)) & 0xFull);
      if (kind == 15) continue;
      KParams kp = get_params();
      unsigned char* ws = kp->ws; unsigned char* R = ws + WS_R; bf16_t* HN = (bf16_t*)(ws + WS_HN);
      if (kind <= K_DOWN) {
        pg8::GemmD g; pg8::EpiD E;
        E.kind = pg8::EK_RES; E.layer = layer;
        g.amode = 0; g.smode = 0; g.nM = 128;
        if (kind == K_RETIN) { g.A = HN; g.Bt = (const bf16_t*)(ws + WS_WMIX); g.K = 1024; g.nN = 24; E.kind = pg8::EK_RETIN; }
        else if (kind == K_RETOUT) { g.A = (const bf16_t*)(R + R_V); g.Bt = (const bf16_t*)(ws + WS_WMIX + 12 * MiB); g.K = 2048; g.nN = 4; if (layer == 0) E.layer = -1; }
        else if (kind == K_NSAIN) { g.A = HN; g.Bt = (const bf16_t*)(ws + WS_WMIX); g.K = 1024; g.nN = 11; E.kind = pg8::EK_NSAIN; }
        else if (kind == K_CMP1) { g.A = (const bf16_t*)(R + N_KV); g.Bt = (const bf16_t*)(ws + WS_WMIX + 8 * MiB); g.K = 2048; g.amode = 1; g.smode = 1; g.nM = 64; g.nN = 1; E.kind = pg8::EK_CMP1; }
        else if (kind == K_NSAOUT) { g.A = (const bf16_t*)(R + N_ATT); g.Bt = (const bf16_t*)(ws + WS_WMIX + 6 * MiB); g.K = 1024; g.nN = 4; }
        else if (kind == K_GU) { g.A = HN; g.Bt = (const bf16_t*)(ws + WS_WFFN); g.K = 1024; g.nN = 22; E.kind = pg8::EK_SWIGLU; }
        else { g.A = (const bf16_t*)R; g.Bt = (const bf16_t*)(ws + WS_WFFN + 11 * MiB); g.K = 2816; g.nN = 4; }
#if PROBE_DUP == 3
        if (kind == K_GU) pg8::gemm_phase(lds, g, E, (int)gridDim.x, (int)blockIdx.x);
#endif
#if PROBE_DUP == 7
        if (kind == K_CMP1) pg8::gemm_phase(lds, g, E, (int)gridDim.x, (int)blockIdx.x);
#endif
#if PROBE_DUP == 8
        if (kind == K_RETIN) pg8::gemm_phase(lds, g, E, (int)gridDim.x, (int)blockIdx.x);
#endif
        pg8::gemm_phase(lds, g, E, (int)gridDim.x, (int)blockIdx.x);
        if (kind == K_CMP1) {
          const int Gx = (int)gridDim.x, bx = (int)blockIdx.x; const bool split = Gx > 64;
          if (!split || bx >= 64) conv_ffn((LAS float*)lds, layer, split ? bx - 64 : bx, split ? Gx - 64 : Gx);
          if (!split || bx < 64) {
            __builtin_amdgcn_fence(__ATOMIC_SEQ_CST, "workgroup"); __syncthreads();
            for (int u = bx; u < 64; u += Gx) cmp2_phase((const bf16_t*)(R + N_HID), (const bf16_t*)(ws + WS_WMIX + 10 * MiB), (bf16_t*)(R + N_KC), u * 16);
          }
        }
      } else if (kind == K_SCAN) {
        scan_phase(lds, (const bf16_t*)(R + R_Q), (const bf16_t*)(R + R_K), (bf16_t*)(R + R_V), (float*)(ws + WS_SSQ));
      } else if (kind == K_GATE) {
        conv_ffn((LAS float*)lds, layer);
        gate_phase((bf16_t*)(R + R_V), (const bf16_t*)(R + R_G), (const float*)(ws + WS_SSQ));
#if PROBE_DUP == 6
        conv_ffn((LAS float*)lds, layer);
#endif
      } else if (kind == K_ATTN) {
#if PROBE_DUP == 1
        attn_phase(lds, (const bf16_t*)(R + N_Q), (const bf16_t*)(R + N_KV), (const float*)(R + N_GATES), (const bf16_t*)(R + N_KC), (bf16_t*)(R + N_ATT));
#endif
        attn_phase(lds, (const bf16_t*)(R + N_Q), (const bf16_t*)(R + N_KV), (const float*)(R + N_GATES), (const bf16_t*)(R + N_KC), (bf16_t*)(R + N_ATT));
      } else if (kind == K_NORMFFN) {
        norm_phase(kp->out, kp->norm_ffn + layer * 1024, HN, nullptr);
#if PROBE_DUP == 5
        norm_phase(kp->out, kp->norm_ffn + layer * 1024, HN, nullptr);
#endif
      } else {
        if (layer < 3) { conv_mix((LAS float*)lds, layer + 1); KParams k2 = get_params(); norm_phase(k2->out, k2->norm_mix + (layer + 1) * 1024, (bf16_t*)(k2->ws + WS_HN), nullptr); }
        else norm_phase(kp->out, kp->norm_final, nullptr, kp->out);
      }
      if (layer == 3 && s == 7) break;
      fb.bar = (unsigned*)(get_params()->ws + WS_BAR);
      fast_barrier(fb, (unsigned)__builtin_amdgcn_readfirstlane(layer * 8 + s + 1));
    }
  }
}

extern "C" void kernel_launch(void* const* d_in, const int* in_sizes, int n_in, void* d_out, int out_size, void* d_ws, size_t ws_size, hipStream_t stream) {
  static int grid_blocks = 0;
  if (!grid_blocks) {
    int dev = 0, cus = 0, per_cu = 0;
    hipGetDevice(&dev);
    hipDeviceGetAttribute(&cus, hipDeviceAttributeMultiprocessorCount, dev);
    hipFuncSetAttribute((const void*)mega_fwd, hipFuncAttributeMaxDynamicSharedMemorySize, LDS_BYTES);
    hipOccupancyMaxActiveBlocksPerMultiprocessor(&per_cu, (const void*)mega_fwd, 512, LDS_BYTES);
    if (per_cu < 1) per_cu = 1;
    grid_blocks = cus * 1;
    if (ws_size < 489 * MiB) fprintf(stderr, "kernel_launch: workspace too small: %zu\n", ws_size);
  }
  Params p{};
  p.x = (const float*)d_in[0]; p.pos = (const int*)d_in[1]; p.norm_mix = (const float*)d_in[2]; p.norm_ffn = (const float*)d_in[3]; p.norm_final = (const float*)d_in[4];
  p.ret_w_in = (const float*)d_in[5]; p.ret_w_out = (const float*)d_in[6]; p.nsa_w_in = (const float*)d_in[7]; p.cmp_pos = (const float*)d_in[8]; p.cmp_w1 = (const float*)d_in[9];
  p.cmp_w2 = (const float*)d_in[10]; p.nsa_w_out = (const float*)d_in[11]; p.ffn_w_gu = (const float*)d_in[12]; p.ffn_w_down = (const float*)d_in[13];
  p.out = (float*)d_out; p.ws = (unsigned char*)d_ws;
  (void)hipMemsetAsync((char*)d_ws + WS_BAR, 0, 64 * 4 * 34, stream);
  void* args[] = {&p};
  hipError_t e = hipLaunchCooperativeKernel((const void*)mega_fwd, dim3(grid_blocks), dim3(512), args, LDS_BYTES, stream);
  if (e != hipSuccess) fprintf(stderr, "cooperative launch failed: %s (grid %d)\n", hipGetErrorString(e), grid_blocks);
}
```

```cpp
#ifndef PROBE_DUP
#define PROBE_DUP 0
#endif
#include <hip/hip_runtime.h>
#include <hip/hip_cooperative_groups.h>
#include <cstdio>
namespace cg = cooperative_groups;

#define LAS __attribute__((address_space(3)))
typedef unsigned short bf16_t;
typedef short bf16x8 __attribute__((ext_vector_type(8)));
typedef short bf16x4 __attribute__((ext_vector_type(4)));
typedef float f32x4 __attribute__((ext_vector_type(4)));
typedef unsigned u32x4 __attribute__((ext_vector_type(4)));
typedef unsigned u32x2 __attribute__((ext_vector_type(2)));

constexpr int MT = 32768, SEQ = 4096;
constexpr size_t MiB = 1024 * 1024;
constexpr int LDS_BYTES = 147456;
constexpr size_t WS_WMIX = 0;
constexpr size_t WS_WFFN = 16 * MiB;
constexpr size_t WS_HN = 33 * MiB;
constexpr size_t WS_R = 97 * MiB;
constexpr size_t WS_SSQ = 481 * MiB;
constexpr size_t R_Q = 0, R_K = 64 * MiB, R_V = 128 * MiB, R_G = 256 * MiB;
constexpr size_t N_Q = 0, N_KV = 64 * MiB, N_GATES = 160 * MiB, N_HID = 168 * MiB, N_KC = 176 * MiB, N_ATT = 180 * MiB;

struct Params {
  const float* x; const int* pos; const float* norm_mix; const float* norm_ffn; const float* norm_final;
  const float* ret_w_in; const float* ret_w_out; const float* nsa_w_in; const float* cmp_pos; const float* cmp_w1;
  const float* cmp_w2; const float* nsa_w_out; const float* ffn_w_gu; const float* ffn_w_down;
  float* out; unsigned char* ws;
};

typedef const __attribute__((address_space(4))) Params* KParams;
__device__ __forceinline__ KParams get_params() { KParams q = (KParams)__builtin_amdgcn_kernarg_segment_ptr(); asm volatile("" : "+s"(q)); return q; }
typedef __bf16 bf16x2_t __attribute__((ext_vector_type(2)));
__device__ __forceinline__ unsigned cvt_pk_bf16(float lo, float hi) { bf16x2_t v; v[0] = (__bf16)lo; v[1] = (__bf16)hi; return __builtin_bit_cast(unsigned, v); }
__device__ __forceinline__ float bf2f(unsigned short h) { return __uint_as_float(((unsigned)h) << 16); }
__device__ __forceinline__ float silu_f(float x) { return x * __builtin_amdgcn_rcpf(1.0f + __expf(-x)); }
__device__ __forceinline__ float sigmoid_f(float x) { return __builtin_amdgcn_rcpf(1.0f + __expf(-x)); }
__device__ __forceinline__ bf16x8 tr_read8(LAS unsigned char* a0, LAS unsigned char* a1) {
  bf16x4 lo = __builtin_amdgcn_ds_read_tr16_b64_v4i16((LAS bf16x4*)a0);
  bf16x4 hi = __builtin_amdgcn_ds_read_tr16_b64_v4i16((LAS bf16x4*)a1);
  return __builtin_shufflevector(lo, hi, 0, 1, 2, 3, 4, 5, 6, 7);
}
#define MFMA16(a, b, c) __builtin_amdgcn_mfma_f32_16x16x32_bf16((a), (b), (c), 0, 0, 0)

namespace pg8 {
constexpr int BM = 256, BK = 64, HALF = 128, HTB = HALF * BK * 2, NXCD = 8, WGM = 8;
__device__ __forceinline__ int lds_byte(int r, int c) { const int st = (r >> 4) * 2 + (c >> 5), rr = r & 15, cc = c & 31, ob = rr * 64 + cc * 2; return st * 1024 + (ob ^ (((ob >> 9) & 1) << 5)); }
__device__ __forceinline__ void stage_rc(int b, int& R, int& C) { const int st = b / 1024, sb = b % 1024, swz = sb ^ (((sb >> 9) & 1) << 5); R = (st >> 1) * 16 + swz / 64; C = (st & 1) * 32 + (swz % 64) / 2; }
__device__ __forceinline__ int perm32(int rho) { const int n = rho >> 4, i = rho & 15; return 8 * (i >> 2) + 4 * n + (i & 3); }
struct Unit { int pm, pn; };
struct GemmD { const bf16_t* A; const bf16_t* Bt; int K; int amode; int nM, nN; int smode; };
enum { EK_RES = 0, EK_RETIN = 1, EK_NSAIN = 2, EK_SWIGLU = 3, EK_CMP1 = 4 };
struct EpiD { int kind; int layer; };
struct EpiP { int kind; float* of; const float* base; bf16_t* o0; bf16_t* o1; bf16_t* o2; bf16_t* o3; float* gates; const int* pos; const float* bias; };

__device__ __forceinline__ bool unit_next(const GemmD& g, int i, int G, int c, Unit& u) {
  const long L = (long)i * G + c; const int nwg = g.nM * g.nN; if (L >= nwg) return false;
  if (g.smode == 1) { u.pm = (int)L; u.pn = (int)(L >> 5); return true; }
  int wgid = (int)L; { const int q = nwg / NXCD, r = nwg % NXCD, xcd = wgid % NXCD, off = wgid / NXCD; wgid = (xcd < r ? xcd * (q + 1) : r * (q + 1) + (xcd - r) * q) + off; }
  const int nig = WGM * g.nN, gid = wgid / nig, fm = gid * WGM, gsz = (g.nM - fm) < WGM ? (g.nM - fm) : WGM;
  u.pm = fm + ((wgid % nig) % gsz); u.pn = (wgid % nig) / gsz; return true;
}

__device__ __forceinline__ void store8(bf16_t* p, const f32x4 a, const f32x4 b) {
  u32x4 w; w.x = cvt_pk_bf16(a[0], a[1]); w.y = cvt_pk_bf16(a[2], a[3]); w.z = cvt_pk_bf16(b[0], b[1]); w.w = cvt_pk_bf16(b[2], b[3]); *(u32x4*)p = w;
}

__device__ __forceinline__ void epilogue(const EpiD& ED, f32x4 (&acc)[2][2][4][2], const Unit& u, int wr, int wc, int fr, int fq) {
  asm volatile("" : "+v"(fr), "+v"(fq));
  asm volatile("" : "+s"(wr), "+s"(wc));
  EpiP E;
  { KParams kp = get_params(); unsigned char* ws = kp->ws; unsigned char* R = ws + WS_R; float* outp = kp->out;
    E.kind = ED.kind; E.of = outp; E.base = (ED.layer < 0) ? kp->x : outp; E.pos = kp->pos;
    E.o0 = (bf16_t*)R; E.o1 = (bf16_t*)(R + 64 * MiB); E.o2 = (bf16_t*)(R + R_V); E.o3 = (bf16_t*)(R + R_G); E.gates = (float*)(R + N_GATES); E.bias = (const float*)(ws + WS_WMIX + 10 * MiB + 65536);
    if (ED.kind == EK_CMP1) E.o0 = (bf16_t*)(R + N_HID); }
  const int row0 = u.pm * BM + wr * 64 + fr;
  if (E.kind == EK_RES) {
    const int col0 = u.pn * BM + wc * 32 + 4 * fq;
#pragma unroll
    for (int ai = 0; ai < 2; ++ai) {
      f32x4 bs[4][2][2];
#pragma unroll
      for (int m = 0; m < 4; ++m) { const size_t off = (size_t)(row0 + ai * HALF + m * 16) * 1024 + col0;
#pragma unroll
        for (int bj = 0; bj < 2; ++bj)
#pragma unroll
          for (int n = 0; n < 2; ++n) bs[m][bj][n] = *(const f32x4*)(E.base + off + bj * HALF + n * 16); }
      asm volatile("" ::: "memory");
#pragma unroll
      for (int m = 0; m < 4; ++m) { const size_t off = (size_t)(row0 + ai * HALF + m * 16) * 1024 + col0;
#pragma unroll
        for (int bj = 0; bj < 2; ++bj)
#pragma unroll
          for (int n = 0; n < 2; ++n) *(f32x4*)(E.of + off + bj * HALF + n * 16) = bs[m][bj][n] + acc[ai][bj][m][n]; }
    }
  } else if (E.kind == EK_SWIGLU) {
    const int col0 = u.pn * 128 + wc * 32 + 8 * fq;
#pragma unroll
    for (int ai = 0; ai < 2; ++ai)
#pragma unroll
      for (int m = 0; m < 4; ++m) {
        f32x4 h0, h1;
#pragma unroll
        for (int j = 0; j < 4; ++j) { h0[j] = silu_f(acc[ai][0][m][0][j]) * acc[ai][1][m][0][j]; h1[j] = silu_f(acc[ai][0][m][1][j]) * acc[ai][1][m][1][j]; }
        store8(E.o0 + (size_t)(row0 + ai * HALF + m * 16) * 2816 + col0, h0, h1);
      }
  } else if (E.kind == EK_CMP1) {
    const int which = u.pm >> 5;
#pragma unroll
    for (int bj = 0; bj < 2; ++bj) {
      const int c0 = bj * HALF + wc * 32 + 8 * fq;
      f32x4 b0 = {0.f, 0.f, 0.f, 0.f}, b1 = b0;
#pragma unroll
      for (int sg = 0; sg < 8; ++sg) { b0 += *(const f32x4*)(E.bias + (which * 8 + sg) * 256 + c0); b1 += *(const f32x4*)(E.bias + (which * 8 + sg) * 256 + c0 + 4); }
#pragma unroll
      for (int ai = 0; ai < 2; ++ai)
#pragma unroll
        for (int m = 0; m < 4; ++m) {
          f32x4 h0, h1;
#pragma unroll
          for (int j = 0; j < 4; ++j) { h0[j] = silu_f(acc[ai][bj][m][0][j] + b0[j]); h1[j] = silu_f(acc[ai][bj][m][1][j] + b1[j]); }
          store8(E.o0 + (size_t)(row0 + ai * HALF + m * 16) * 256 + c0, h0, h1);
        }
    }
  } else if (E.kind == EK_RETIN) {
    const int pn = u.pn;
    if (pn < 8) {
      bf16_t* dst = (pn < 4) ? (E.o0 + pn * 256) : (E.o1 + (pn - 4) * 256);
      const float scale = (pn < 4) ? 1.0f : 0.0625f;
      float frq[2][4];
#pragma unroll
      for (int n = 0; n < 2; ++n)
#pragma unroll
        for (int j = 0; j < 4; ++j) { const int jj = 32 * wc + 8 * fq + 4 * n + j; frq[n][j] = exp2f(-(float)jj * (13.287712379549449f / 128.0f)) * 0.15915494309189535f; }
      float pfv[2][4];
#pragma unroll
      for (int ai = 0; ai < 2; ++ai)
#pragma unroll
        for (int m = 0; m < 4; ++m) pfv[ai][m] = (float)E.pos[row0 + ai * HALF + m * 16];
#pragma unroll
      for (int ai = 0; ai < 2; ++ai)
#pragma unroll
        for (int m = 0; m < 4; ++m) {
          const int row = row0 + ai * HALF + m * 16; const float pf = pfv[ai][m];
          f32x4 r1[2], r2[2];
#pragma unroll
          for (int n = 0; n < 2; ++n)
#pragma unroll
            for (int j = 0; j < 4; ++j) {
              float xx = pf * frq[n][j]; xx = xx - floorf(xx);
              const float s = __builtin_amdgcn_sinf(xx), c = __builtin_amdgcn_cosf(xx);
              const float x1 = acc[ai][0][m][n][j] * scale, x2 = acc[ai][1][m][n][j] * scale;
              r1[n][j] = x1 * c - x2 * s; r2[n][j] = x2 * c + x1 * s;
            }
          bf16_t* rp = dst + (size_t)row * 1024 + wc * 32 + 8 * fq;
          store8(rp, r1[0], r1[1]); store8(rp + 128, r2[0], r2[1]);
        }
    } else {
      bf16_t* dst = (pn < 16) ? (E.o2 + (pn - 8) * 256) : (E.o3 + (pn - 16) * 256);
#pragma unroll
      for (int ai = 0; ai < 2; ++ai)
#pragma unroll
        for (int m = 0; m < 4; ++m) {
          bf16_t* rp = dst + (size_t)(row0 + ai * HALF + m * 16) * 2048 + wc * 32 + 8 * fq;
          store8(rp, acc[ai][0][m][0], acc[ai][0][m][1]); store8(rp + 128, acc[ai][1][m][0], acc[ai][1][m][1]);
        }
    }
  } else {
    const int pn = u.pn;
    if (pn < 10) {
      const bool rot = (pn < 4) || (((pn - 4) & 1) == 0);
      bf16_t* dst; int ldo;
      if (pn < 4) { dst = E.o0 + pn * 256; ldo = 1024; } else { dst = E.o1 + (size_t)(pn - 4) * ((size_t)MT * 256); ldo = 256; }
      float frq[2][4];
#pragma unroll
      for (int n = 0; n < 2; ++n)
#pragma unroll
        for (int j = 0; j < 4; ++j) frq[n][j] = exp2f(-(float)(4 * n + j) * (18.931568569324174f / 8.0f)) * 0.15915494309189535f;
      float pfv[2][4];
#pragma unroll
      for (int ai = 0; ai < 2; ++ai)
#pragma unroll
        for (int m = 0; m < 4; ++m) pfv[ai][m] = (float)E.pos[row0 + ai * HALF + m * 16];
#pragma unroll
      for (int ai = 0; ai < 2; ++ai)
#pragma unroll
        for (int m = 0; m < 4; ++m) {
          const int row = row0 + ai * HALF + m * 16; const float pf = pfv[ai][m];
#pragma unroll
          for (int bj = 0; bj < 2; ++bj) {
            f32x4 v0 = acc[ai][bj][m][0], v1 = acc[ai][bj][m][1];
            if (rot && ((wc & 1) == 0)) {
#pragma unroll
              for (int n = 0; n < 2; ++n)
#pragma unroll
                for (int j = 0; j < 4; ++j) {
                  float xx = pf * frq[n][j]; xx = xx - floorf(xx);
                  const float s = __builtin_amdgcn_sinf(xx), c = __builtin_amdgcn_cosf(xx);
                  const float own = (n == 0) ? v0[j] : v1[j];
                  const float oth = __shfl_xor(own, 16);
                  const float res = (fq == 0) ? (own * c - oth * s) : ((fq == 1) ? (own * c + oth * s) : own);
                  if (n == 0) v0[j] = res; else v1[j] = res;
                }
            }
            store8(dst + (size_t)row * ldo + bj * HALF + wc * 32 + 8 * fq, v0, v1);
          }
        }
    } else {
      if (wc < 2) {
#pragma unroll
        for (int ai = 0; ai < 2; ++ai)
#pragma unroll
          for (int m = 0; m < 4; ++m) {
            const int row = row0 + ai * HALF + m * 16;
#pragma unroll
            for (int n = 0; n < 2; ++n) {
              const int c = wc * 32 + 8 * fq + 4 * n;
              if (c < 48) { const f32x4 v = acc[ai][0][m][n]; f32x4 o; o[0] = sigmoid_f(v[0]); o[1] = sigmoid_f(v[1]); o[2] = sigmoid_f(v[2]); o[3] = sigmoid_f(v[3]); *(f32x4*)(E.gates + (size_t)row * 48 + c) = o; }
            }
          }
      }
    }
  }
}

__device__ __forceinline__ void gemm_phase(LAS unsigned char* lds, const GemmD g, const EpiD E, const int G, const int cid) {
  int tid_ = threadIdx.x; asm volatile("" : "+v"(tid_));
  const int tid = tid_, wid = __builtin_amdgcn_readfirstlane(tid >> 6), lane = tid & 63, wr = wid >> 2, wc = wid & 3, fr = lane & 15, fq = lane >> 4;
  const int K = g.K, nt = K / BK;
  const bool perm = (E.kind != EK_RES);
  unsigned voffA[2], voffB[2];
#pragma unroll
  for (int i = 0; i < 2; ++i) { int R, C; stage_rc(tid * 16 + i * 8192, R, C); const int Rb = perm ? ((R & ~31) + perm32(R & 31)) : R;
    voffA[i] = g.amode ? (unsigned)(((R >> 2) * 4096 + (R & 3) * 64) + C) * 2u : (unsigned)(R * K + C) * 2u; voffB[i] = (unsigned)(Rb * K + C) * 2u; }
  const size_t kstepB = (size_t)(BK * 2), hstepB = (size_t)HALF * K * 2, tstepB = 2 * hstepB;
  const size_t kstepA = g.amode ? (size_t)512 : kstepB, hstepA = g.amode ? (size_t)32 * 4096 * 2 : hstepB, tstepA = 2 * hstepA;
  const unsigned ldsw = (unsigned)wid * 1024u;
  const int aoff = lds_byte(wr * 64 + fr, fq * 8), boff = lds_byte(wc * 32 + fr, fq * 8);
#define PG8_SA(b, h) (((b) * 2 + (h)) * HTB)
#define PG8_SB(b, h) ((4 + (b) * 2 + (h)) * HTB)
#define PG8_STAGE(bufoff, gbase, voff) do { _Pragma("unroll") for (int _i = 0; _i < 2; ++_i) \
    __builtin_amdgcn_global_load_lds((const unsigned*)((const char*)(gbase) + (voff)[_i]), (LAS unsigned*)(lds + (bufoff) + ldsw + _i * 8192), 16, 0, 0); } while (0)
#define PG8_LDA(dst, b, h) do { _Pragma("unroll") for (int m = 0; m < 4; ++m) _Pragma("unroll") for (int k = 0; k < 2; ++k) dst[m][k] = *(const LAS bf16x8*)(lds + PG8_SA(b, h) + aoff + m * 2048 + k * 1024); } while (0)
#define PG8_LDB(dst, b, h) do { _Pragma("unroll") for (int n = 0; n < 2; ++n) _Pragma("unroll") for (int k = 0; k < 2; ++k) dst[n][k] = *(const LAS bf16x8*)(lds + PG8_SB(b, h) + boff + n * 2048 + k * 1024); } while (0)
#define PG8_MMA(ai, bj, At, Bt) do { __builtin_amdgcn_s_setprio(1); _Pragma("unroll") for (int m = 0; m < 4; ++m) _Pragma("unroll") for (int n = 0; n < 2; ++n) _Pragma("unroll") for (int k = 0; k < 2; ++k) \
    acc[ai][bj][m][n] = __builtin_amdgcn_mfma_f32_16x16x32_bf16(Bt[n][k], At[m][k], acc[ai][bj][m][n], 0, 0, 0); __builtin_amdgcn_s_setprio(0); } while (0)
#define PG8_WAIT_V(n) asm volatile("s_waitcnt vmcnt(" #n ")" ::: "memory")
#define PG8_WAIT_L(n) asm volatile("s_waitcnt lgkmcnt(" #n ")" ::: "memory")
#define PG8_BAR __builtin_amdgcn_s_barrier()
#define PG8_SCHED __builtin_amdgcn_sched_barrier(0)
  Unit cur, nxt; int ui = 0;
  if (!unit_next(g, 0, G, cid, cur)) return;
  f32x4 acc[2][2][4][2];
#pragma unroll
  for (int a = 0; a < 2; ++a)
#pragma unroll
    for (int b = 0; b < 2; ++b)
#pragma unroll
      for (int m = 0; m < 4; ++m)
#pragma unroll
        for (int n = 0; n < 2; ++n) acc[a][b][m][n] = (f32x4){0.f, 0.f, 0.f, 0.f};
  bf16x8 At[4][2], B0[2][2], B1[2][2];
  const char* cA = (const char*)g.A + (size_t)cur.pm * tstepA; const char* cB = (const char*)g.Bt + (size_t)cur.pn * tstepB;
  PG8_STAGE(PG8_SB(0, 0), cB, voffB); PG8_STAGE(PG8_SA(0, 0), cA, voffA); PG8_STAGE(PG8_SB(0, 1), cB + hstepB, voffB); PG8_STAGE(PG8_SA(0, 1), cA + hstepA, voffA);
  if (wr == 1) PG8_BAR;
  PG8_WAIT_V(4); PG8_BAR;
  PG8_STAGE(PG8_SB(1, 0), cB + kstepB, voffB); PG8_STAGE(PG8_SA(1, 0), cA + kstepA, voffA); PG8_STAGE(PG8_SB(1, 1), cB + hstepB + kstepB, voffB);
  PG8_WAIT_V(6); PG8_BAR;
  for (;;) {
    const bool has_next = unit_next(g, ui + 1, G, cid, nxt);
    const char* nA = has_next ? (const char*)g.A + (size_t)nxt.pm * tstepA : cA; const char* nB = has_next ? (const char*)g.Bt + (size_t)nxt.pn * tstepB : cB;
    for (int t = 0; t < nt; t += 2) {
      const bool last = (t == nt - 2);
      const char* a1 = cA + (size_t)(t + 1) * kstepA;
      const char* a2 = last ? nA : cA + (size_t)(t + 2) * kstepA; const char* b2 = last ? nB : cB + (size_t)(t + 2) * kstepB;
      const char* a3 = a2 + kstepA; const char* b3 = b2 + kstepB;
      PG8_LDB(B0, 0, 0); PG8_SCHED; PG8_LDA(At, 0, 0); PG8_STAGE(PG8_SA(1, 1), a1 + hstepA, voffA);
      PG8_WAIT_L(8); PG8_BAR; PG8_WAIT_L(0); PG8_MMA(0, 0, At, B0); PG8_BAR; PG8_SCHED;
      PG8_LDB(B1, 0, 1); PG8_STAGE(PG8_SB(0, 0), b2, voffB);
      PG8_BAR; PG8_WAIT_L(0); PG8_MMA(0, 1, At, B1); PG8_BAR;
      PG8_LDA(At, 0, 1); PG8_STAGE(PG8_SA(0, 0), a2, voffA);
      PG8_BAR; PG8_WAIT_L(0); PG8_MMA(1, 0, At, B0); PG8_BAR; PG8_SCHED;
      PG8_STAGE(PG8_SB(0, 1), b2 + hstepB, voffB);
      PG8_WAIT_V(6); PG8_BAR; PG8_MMA(1, 1, At, B1); PG8_BAR;
      PG8_LDB(B0, 1, 0); PG8_SCHED; PG8_LDA(At, 1, 0); PG8_STAGE(PG8_SA(0, 1), a2 + hstepA, voffA);
      PG8_WAIT_L(8); PG8_BAR; PG8_WAIT_L(0); PG8_MMA(0, 0, At, B0); PG8_BAR; PG8_SCHED;
      PG8_LDB(B1, 1, 1); PG8_STAGE(PG8_SB(1, 0), b3, voffB);
      PG8_BAR; PG8_WAIT_L(0); PG8_MMA(0, 1, At, B1); PG8_BAR;
      PG8_LDA(At, 1, 1); PG8_STAGE(PG8_SA(1, 0), a3, voffA);
      PG8_BAR; PG8_WAIT_L(0); PG8_MMA(1, 0, At, B0); PG8_BAR; PG8_SCHED;
      PG8_STAGE(PG8_SB(1, 1), b3 + hstepB, voffB);
      PG8_WAIT_V(6); PG8_BAR; PG8_MMA(1, 1, At, B1); PG8_BAR;
    }
    epilogue(E, acc, cur, wr, wc, fr, fq);
    if (!has_next) break;
#pragma unroll
    for (int a = 0; a < 2; ++a)
#pragma unroll
      for (int b = 0; b < 2; ++b)
#pragma unroll
        for (int m = 0; m < 4; ++m)
#pragma unroll
          for (int n = 0; n < 2; ++n) acc[a][b][m][n] = (f32x4){0.f, 0.f, 0.f, 0.f};
    cur = nxt; cA = nA; cB = nB; ++ui;
  }
  PG8_WAIT_V(0);
  if (wr == 0) PG8_BAR;
  PG8_BAR;
#undef PG8_SA
#undef PG8_SB
#undef PG8_STAGE
#undef PG8_LDA
#undef PG8_LDB
#undef PG8_MMA
#undef PG8_WAIT_V
#undef PG8_WAIT_L
#undef PG8_BAR
#undef PG8_SCHED
}
}

__device__ __forceinline__ void conv_matrix(LAS float* tile, const float* W, int K, int N, bf16_t* Wt, int Ndst, int mapkind, int rot, int vb = -1, int vg = 0) {
  int tid_ = threadIdx.x; asm volatile("" : "+v"(tid_));
  const int tid = tid_, G = (vb < 0) ? (int)gridDim.x : vg; const int bidx = (vb < 0) ? (int)blockIdx.x : vb;
  const int nK = K >> 6, njobs = nK * (Ndst >> 6);
  for (int job = (bidx + rot) % G; job < njobs; job += G) {
    const int kt = job % nK, dn0 = (job / nK) * 64;
    int sn0, nvalid;
    if (mapkind == 0) { sn0 = dn0; nvalid = N - dn0; nvalid = nvalid < 0 ? 0 : (nvalid > 64 ? 64 : nvalid); }
    else { const int pn = dn0 >> 8, rem = dn0 & 255; sn0 = (rem >> 7) * 2816 + pn * 128 + (rem & 127); nvalid = 64; }
    { const int i = tid >> 3, j8 = (tid & 7) * 8; f32x4 a = {0.f, 0.f, 0.f, 0.f}, b = a;
      if (j8 < nvalid) { const float* s = W + (size_t)(kt * 64 + i) * N + sn0 + j8; a = *(const f32x4*)s; b = *(const f32x4*)(s + 4); }
#pragma unroll
      for (int e = 0; e < 4; ++e) { tile[i * 65 + j8 + e] = a[e]; tile[i * 65 + j8 + 4 + e] = b[e]; } }
    __syncthreads();
    { const int n = tid >> 3, k8 = (tid & 7) * 8; float v[8];
#pragma unroll
      for (int e = 0; e < 8; ++e) v[e] = tile[(k8 + e) * 65 + n];
      u32x4 w; w.x = cvt_pk_bf16(v[0], v[1]); w.y = cvt_pk_bf16(v[2], v[3]); w.z = cvt_pk_bf16(v[4], v[5]); w.w = cvt_pk_bf16(v[6], v[7]);
      *(u32x4*)(Wt + (size_t)(dn0 + n) * K + kt * 64 + k8) = w; }
    __syncthreads();
  }
}

__device__ __forceinline__ void conv_mix(LAS float* tile, int layer) {
  KParams kp = get_params(); unsigned char* ws = kp->ws; const int j = layer >> 1;
  if ((layer & 1) == 0) {
    conv_matrix(tile, kp->ret_w_in + (size_t)j * 1024 * 6144, 1024, 6144, (bf16_t*)(ws + WS_WMIX), 6144, 0, 0);
    conv_matrix(tile, kp->ret_w_out + (size_t)j * 2048 * 1024, 2048, 1024, (bf16_t*)(ws + WS_WMIX + 12 * MiB), 1024, 0, 0);
  } else {
    conv_matrix(tile, kp->nsa_w_in + (size_t)j * 1024 * 2608, 1024, 2608, (bf16_t*)(ws + WS_WMIX), 2816, 0, 0);
    conv_matrix(tile, kp->nsa_w_out + (size_t)j * 1024 * 1024, 1024, 1024, (bf16_t*)(ws + WS_WMIX + 6 * MiB), 1024, 0, 192);
    for (int which = 0; which < 2; ++which) {
      conv_matrix(tile, kp->cmp_w1 + (size_t)(j * 2 + which) * 2048 * 256, 2048, 256, (bf16_t*)(ws + WS_WMIX + 8 * MiB) + (size_t)which * 256 * 2048, 256, 0, 64 + which * 128);
      conv_matrix(tile, kp->cmp_w2 + (size_t)(j * 2 + which) * 256 * 64, 256, 64, (bf16_t*)(ws + WS_WMIX + 10 * MiB) + (size_t)which * 64 * 256, 64, 0, 32 + which * 8);
    }
    const int bw = (int)blockIdx.x - 100;
    if (bw >= 0 && bw < 16) {
      int tid_ = threadIdx.x; asm volatile("" : "+v"(tid_)); const int which = bw >> 3, kseg = bw & 7, tid = tid_, c = tid & 255, half = tid >> 8;
      const float* pos = kp->cmp_pos + (size_t)(j * 2 + which) * 2048; const float* w1 = kp->cmp_w1 + (size_t)(j * 2 + which) * 2048 * 256;
      const int k0 = kseg * 256 + half * 128;
      float s = 0.f;
#pragma unroll 1
      for (int kk = 0; kk < 128; kk += 16) { float pv[16], wv[16];
#pragma unroll
        for (int e = 0; e < 16; ++e) { pv[e] = pos[k0 + kk + e]; wv[e] = w1[(size_t)(k0 + kk + e) * 256 + c]; }
#pragma unroll
        for (int e = 0; e < 16; ++e) s += pv[e] * wv[e]; }
      tile[tid] = s; __syncthreads();
      if (tid < 256) ((float*)(ws + WS_WMIX + 10 * MiB + 65536))[(which * 8 + kseg) * 256 + c] = tile[tid] + tile[tid + 256];
      __syncthreads();
    }
  }
}
__device__ __forceinline__ void conv_ffn(LAS float* tile, int layer, int vb = -1, int vg = 0) {
  KParams kp = get_params();
  conv_matrix(tile, kp->ffn_w_gu + (size_t)layer * 1024 * 5632, 1024, 5632, (bf16_t*)(kp->ws + WS_WFFN), 5632, 1, 0, vb, vg);
  conv_matrix(tile, kp->ffn_w_down + (size_t)layer * 2816 * 1024, 2816, 1024, (bf16_t*)(kp->ws + WS_WFFN + 11 * MiB), 1024, 0, 128, vb, vg);
}

__device__ __forceinline__ void norm_phase(const float* x, const float* gain, bf16_t* hn, float* outf) {
  int tid_ = threadIdx.x; asm volatile("" : "+v"(tid_));
  const int lane = tid_ & 63, wave = tid_ >> 6, nw = gridDim.x * 8;
  f32x4 gv[4];
#pragma unroll
  for (int i = 0; i < 4; ++i) gv[i] = *(const f32x4*)(gain + i * 256 + lane * 4);
  for (int row = blockIdx.x * 8 + wave; row < MT; row += nw) {
    const float* xr = x + (size_t)row * 1024; f32x4 v[4]; float s = 0.f;
#pragma unroll
    for (int i = 0; i < 4; ++i) { v[i] = *(const f32x4*)(xr + i * 256 + lane * 4); s += v[i][0] * v[i][0] + v[i][1] * v[i][1] + v[i][2] * v[i][2] + v[i][3] * v[i][3]; }
#pragma unroll
    for (int o = 32; o >= 1; o >>= 1) s += __shfl_xor(s, o);
    const float rs = rsqrtf(s * (1.0f / 1024.0f) + 1e-6f);
#pragma unroll
    for (int i = 0; i < 4; ++i) {
      const f32x4 y = v[i] * rs * gv[i];
      if (outf) *(f32x4*)(outf + (size_t)row * 1024 + i * 256 + lane * 4) = y;
      else { u32x2 w; w.x = cvt_pk_bf16(y[0], y[1]); w.y = cvt_pk_bf16(y[2], y[3]); *(u32x2*)(hn + (size_t)row * 1024 + i * 256 + lane * 4) = w; }
    }
  }
}

constexpr int SC_QS = 0, SC_KS = 33792, SC_VS = 67584, SC_VD = 76800, SC_PS = 86016, SC_ST = 95232;
__device__ __forceinline__ void scan_phase(LAS unsigned char* lds, const bf16_t* Q, const bf16_t* Kb, bf16_t* V, float* ssq) {
  int tid_ = threadIdx.x; asm volatile("" : "+v"(tid_));
  const int tid = tid_, wave = __builtin_amdgcn_readfirstlane(tid >> 6), lane = tid & 63, fr = lane & 15, fq = lane >> 4;
  const int tq = (lane & 15) >> 2, tp = lane & 3;
  for (int item = blockIdx.x; item < 256; item += gridDim.x) {
    const int ity = (gridDim.x == 256) ? (((item & 7) * 4 + (item >> 6)) * 8 + ((item >> 3) & 7)) : item;
    const int b = ity >> 5, h = (ity >> 3) & 3, es = ity & 7;
    const float l2g = log2f(1.0f - exp2f(-5.0f - (float)h));
    const bf16_t* qb = Q + (size_t)b * SEQ * 1024 + h * 256; const bf16_t* kb = Kb + (size_t)b * SEQ * 1024 + h * 256;
    bf16_t* vb = V + (size_t)b * SEQ * 2048 + h * 512 + es * 64;
    f32x4 st[4][2];
#pragma unroll
    for (int a = 0; a < 4; ++a) { st[a][0] = (f32x4){0.f, 0.f, 0.f, 0.f}; st[a][1] = st[a][0]; }
    for (int i = tid; i < 33792 / 16; i += 512) *(LAS u32x4*)(lds + SC_ST + i * 16) = (u32x4){0u, 0u, 0u, 0u};
    u32x4 rq[4], rk[4], rv;
    const int vrow = tid >> 3, vc16 = tid & 7;
#define SC_LOAD(c) do { _Pragma("unroll") for (int i = 0; i < 4; ++i) { const int pp = tid + 512 * i, row = pp >> 5, c16 = pp & 31; \
      rq[i] = *(const u32x4*)(qb + (size_t)((c) * 64 + row) * 1024 + c16 * 8); rk[i] = *(const u32x4*)(kb + (size_t)((c) * 64 + row) * 1024 + c16 * 8); } \
      rv = *(const u32x4*)(vb + (size_t)((c) * 64 + vrow) * 2048 + vc16 * 8); } while (0)
    SC_LOAD(0);
    const float cdecay = exp2f(l2g * 64.0f);
    for (int c = 0; c < 64; ++c) {
#pragma unroll
      for (int i = 0; i < 4; ++i) { const int pp = tid + 512 * i, row = pp >> 5, c16 = pp & 31;
        *(LAS u32x4*)(lds + SC_QS + row * 528 + c16 * 16) = rq[i]; *(LAS u32x4*)(lds + SC_KS + row * 528 + c16 * 16) = rk[i]; }
      { *(LAS u32x4*)(lds + SC_VS + vrow * 144 + vc16 * 16) = rv;
        const float kd = exp2f(l2g * (float)(63 - vrow)); u32x4 w;
#pragma unroll
        for (int e = 0; e < 4; ++e) { const unsigned u = rv[e]; w[e] = cvt_pk_bf16(__uint_as_float(u << 16) * kd, __uint_as_float(u & 0xffff0000u) * kd); }
        *(LAS u32x4*)(lds + SC_VD + vrow * 144 + vc16 * 16) = w; }
      __syncthreads();
      if (c + 1 < 64) SC_LOAD(c + 1);
      const int rt = wave >> 1, wh = wave & 1;
      bf16x8 qf[8];
#pragma unroll
      for (int ks = 0; ks < 8; ++ks) qf[ks] = *(const LAS bf16x8*)(lds + SC_QS + (16 * rt + fr) * 528 + (32 * ks + 8 * fq) * 2);
#pragma unroll
      for (int cti = 0; cti < 2; ++cti) {
        const int ct = 2 * wh + cti; f32x4 a = {0.f, 0.f, 0.f, 0.f};
        if (ct <= rt) {
#pragma unroll
          for (int ks = 0; ks < 8; ++ks) { const bf16x8 kf = *(const LAS bf16x8*)(lds + SC_KS + (16 * ct + fr) * 528 + (32 * ks + 8 * fq) * 2); a = MFMA16(kf, qf[ks], a); }
        }
        { const int i = 16 * rt + fr, j0 = 16 * ct + 4 * fq; float pv[4];
#pragma unroll
          for (int r = 0; r < 4; ++r) pv[r] = (i >= j0 + r) ? a[r] * exp2f(l2g * (float)(i - j0 - r)) : 0.f;
          u32x2 w; w.x = cvt_pk_bf16(pv[0], pv[1]); w.y = cvt_pk_bf16(pv[2], pv[3]);
          *(LAS u32x2*)(lds + SC_PS + i * 144 + j0 * 2) = w; }
      }
      __syncthreads();
      {
        const int ti = 16 * rt + fr;
        const float qd = exp2f(l2g * (float)(ti + 1));
        bf16x8 pf[2];
#pragma unroll
        for (int ks = 0; ks < 2; ++ks) pf[ks] = *(const LAS bf16x8*)(lds + SC_PS + ti * 144 + (32 * ks + 8 * fq) * 2);
        float sq = 0.f;
#pragma unroll
        for (int eti = 0; eti < 2; ++eti) {
          const int et = 2 * wh + eti; f32x4 a1 = {0.f, 0.f, 0.f, 0.f}, a2 = a1;
#pragma unroll
          for (int ks = 0; ks < 2; ++ks) {
            LAS unsigned char* va = lds + SC_VS + (32 * ks + 8 * fq + tq) * 144 + (16 * et + 4 * tp) * 2;
            const bf16x8 vf = tr_read8(va, va + 4 * 144);
            a1 = MFMA16(vf, pf[ks], a1);
          }
#pragma unroll
          for (int ks = 0; ks < 8; ++ks) { const bf16x8 sf = *(const LAS bf16x8*)(lds + SC_ST + (16 * et + fr) * 528 + (32 * ks + 8 * fq) * 2); a2 = MFMA16(sf, qf[ks], a2); }
          const f32x4 o = a1 + a2 * qd;
          sq += o[0] * o[0] + o[1] * o[1] + o[2] * o[2] + o[3] * o[3];
          u32x2 w; w.x = cvt_pk_bf16(o[0], o[1]); w.y = cvt_pk_bf16(o[2], o[3]);
          *(u32x2*)(vb + (size_t)(c * 64 + ti) * 2048 + 16 * et + 4 * fq) = w;
        }
        sq += __shfl_xor(sq, 16); sq += __shfl_xor(sq, 32);
        if (fq == 0) ssq[((size_t)(b * SEQ + c * 64 + ti) * 4 + h) * 16 + es * 2 + wh] = sq;
      }
      {
        bf16x8 kf[2][2];
#pragma unroll
        for (int dtl = 0; dtl < 2; ++dtl)
#pragma unroll
          for (int ks = 0; ks < 2; ++ks) { LAS unsigned char* ka = lds + SC_KS + (32 * ks + 8 * fq + tq) * 528 + (32 * wave + 16 * dtl + 4 * tp) * 2; kf[dtl][ks] = tr_read8(ka, ka + 4 * 528); }
#pragma unroll
        for (int et = 0; et < 4; ++et) {
          bf16x8 vf[2];
#pragma unroll
          for (int ks = 0; ks < 2; ++ks) { LAS unsigned char* va = lds + SC_VD + (32 * ks + 8 * fq + tq) * 144 + (16 * et + 4 * tp) * 2; vf[ks] = tr_read8(va, va + 4 * 144); }
#pragma unroll
          for (int dtl = 0; dtl < 2; ++dtl) { f32x4 a = st[et][dtl] * cdecay;
#pragma unroll
            for (int ks = 0; ks < 2; ++ks) a = MFMA16(kf[dtl][ks], vf[ks], a);
            st[et][dtl] = a; }
        }
      }
      __syncthreads();
#pragma unroll
      for (int et = 0; et < 4; ++et)
#pragma unroll
        for (int dtl = 0; dtl < 2; ++dtl)
          { u32x2 w; w.x = cvt_pk_bf16(st[et][dtl][0], st[et][dtl][1]); w.y = cvt_pk_bf16(st[et][dtl][2], st[et][dtl][3]);
            *(LAS u32x2*)(lds + SC_ST + (16 * et + fr) * 528 + (32 * wave + 16 * dtl + 4 * fq) * 2) = w; }
    }
    __syncthreads();
#undef SC_LOAD
  }
}

__device__ __forceinline__ void gate_phase(bf16_t* V, const bf16_t* Gt, const float* ssq) {
  int tid_ = threadIdx.x; asm volatile("" : "+v"(tid_));
  const int lane = tid_ & 63, wave = tid_ >> 6, nw = gridDim.x * 8;
  for (int u = blockIdx.x * 8 + wave; u < MT * 4; u += nw) {
    float s = (lane < 16) ? ssq[(size_t)u * 16 + lane] : 0.f;
    s += __shfl_xor(s, 1); s += __shfl_xor(s, 2); s += __shfl_xor(s, 4); s += __shfl_xor(s, 8);
    s = __shfl(s, 0);
    const float rs = rsqrtf(s * (1.0f / 512.0f) + 1e-6f);
    const size_t off = (size_t)u * 512 + lane * 8;
    const u32x4 o = *(const u32x4*)(V + off), g = *(const u32x4*)(Gt + off); u32x4 w;
#pragma unroll
    for (int e = 0; e < 4; ++e) {
      const float o0 = __uint_as_float(o[e] << 16), o1 = __uint_as_float(o[e] & 0xffff0000u), g0 = __uint_as_float(g[e] << 16), g1 = __uint_as_float(g[e] & 0xffff0000u);
      w[e] = cvt_pk_bf16(o0 * rs * silu_f(g0), o1 * rs * silu_f(g1));
    }
    *(u32x4*)(V + off) = w;
  }
}

__device__ __forceinline__ void cmp2_phase(const bf16_t* hid, const bf16_t* w2t, bf16_t* kc, int it0 = -1) {
  int tid_ = threadIdx.x; asm volatile("" : "+v"(tid_));
  const int lane = tid_ & 63, wave = tid_ >> 6, nw = gridDim.x * 8, fr = lane & 15, fq = lane >> 4;
  for (int it = it0 + wave; it < it0 + 16; it += 8) {
    const int which = it >> 9;
    bf16x8 af[8];
#pragma unroll
    for (int ks = 0; ks < 8; ++ks) af[ks] = *(const bf16x8*)(hid + (size_t)(it * 16 + fr) * 256 + 32 * ks + 8 * fq);
#pragma unroll
    for (int ct = 0; ct < 4; ++ct) {
      f32x4 a = {0.f, 0.f, 0.f, 0.f};
#pragma unroll
      for (int ks = 0; ks < 8; ++ks) { const bf16x8 bf = *(const bf16x8*)(w2t + (size_t)which * 64 * 256 + (size_t)(16 * ct + fr) * 256 + 32 * ks + 8 * fq); a = MFMA16(af[ks], bf, a); }
#pragma unroll
      for (int r = 0; r < 4; ++r) {
        const int rr = (it * 16 + 4 * fq + r) & 8191, b = rr >> 10, n = (rr >> 2) & 255, g = rr & 3;
        const float v = (n == 255) ? 0.f : a[r];
        kc[(size_t)which * (8 * 4 * 256 * 64) + ((size_t)((b * 4 + g) * 256 + n)) * 64 + 16 * ct + fr] = (unsigned short)(cvt_pk_bf16(v, 0.f) & 0xffffu);
      }
    }
  }
}

constexpr int AT_KC = 0, AT_VC = 36864, AT_PS = 73728, AT_VALS = 106496, AT_PARK = 114688;
template <int MM>
__device__ __forceinline__ void flash_block2(LAS unsigned char* kt_, LAS unsigned char* vt_, const bf16x8 (&qf)[2][2], f32x4 (&ot)[2][4], float (&mrun)[2], float (&lrun)[2],
                                             const int fr, const int fq, const int tq, const int tp, const int mode, const int pos0, const int (&t)[2], const unsigned long long (&selmask)[2], const int nblk) {
  f32x4 s[2][4];
  __builtin_amdgcn_s_setprio(1);
#pragma unroll
  for (int kt = 0; kt < 4; ++kt) { f32x4 a0 = {0.f, 0.f, 0.f, 0.f}, a1 = a0;
#pragma unroll
    for (int ks = 0; ks < 2; ++ks) { const bf16x8 kf = *(const LAS bf16x8*)(kt_ + (16 * kt + fr) * 144 + (32 * ks + 8 * fq) * 2); a0 = MFMA16(kf, qf[0][ks], a0); a1 = MFMA16(kf, qf[1][ks], a1); }
    s[0][kt] = a0; s[1][kt] = a1; __builtin_amdgcn_sched_barrier(0); }
  __builtin_amdgcn_s_setprio(0);
#pragma unroll
  for (int rg = 0; rg < 2; ++rg) {
    const bool rowsel = (mode == 0) ? ((selmask[rg] >> nblk) & 1ull) != 0ull : true;
    float mx = -1e30f;
    if (MM == 0) {
#pragma unroll
      for (int kt = 0; kt < 4; ++kt)
#pragma unroll
        for (int r = 0; r < 4; ++r) { const int pos = pos0 + 16 * kt + 4 * fq + r; const bool v = rowsel && (pos <= t[rg]) && (mode == 0 || pos > t[rg] - 512);
          const float sv = v ? s[rg][kt][r] : -1e30f; s[rg][kt][r] = sv; mx = fmaxf(mx, sv); }
    } else {
#pragma unroll
      for (int kt = 0; kt < 4; ++kt) mx = fmaxf(fmaxf(mx, fmaxf(s[rg][kt][0], s[rg][kt][1])), fmaxf(s[rg][kt][2], s[rg][kt][3]));
      if (MM == 1 && !rowsel) mx = -1e30f;
    }
    mx = fmaxf(mx, __shfl_xor(mx, 16)); mx = fmaxf(mx, __shfl_xor(mx, 32));
    const float mnew = fmaxf(mrun[rg], mx); const bool moved = mnew != mrun[rg];
    const float msub = (MM == 1 && !rowsel) ? 1e30f : mnew;
    float ls = 0.f;
#pragma unroll
    for (int kt = 0; kt < 4; ++kt)
#pragma unroll
      for (int r = 0; r < 4; ++r) { float pv = __builtin_amdgcn_exp2f(s[rg][kt][r] - msub);
        if (MM == 0) pv = (s[rg][kt][r] > -1e29f) ? pv : 0.f;
        s[rg][kt][r] = pv; ls += pv; }
    if (__ballot(moved) != 0ull) {
      const float alpha = __builtin_amdgcn_exp2f(mrun[rg] - mnew); lrun[rg] *= alpha;
#pragma unroll
      for (int dt = 0; dt < 4; ++dt) ot[rg][dt] *= alpha;
    }
    mrun[rg] = mnew; lrun[rg] += ls;
    __builtin_amdgcn_sched_barrier(0);
  }
  __builtin_amdgcn_s_setprio(1);
#pragma unroll
  for (int kk = 0; kk < 2; ++kk) {
    bf16x8 pf[2];
#pragma unroll
    for (int rg = 0; rg < 2; ++rg) { u32x4 w; w.x = cvt_pk_bf16(s[rg][2 * kk][0], s[rg][2 * kk][1]); w.y = cvt_pk_bf16(s[rg][2 * kk][2], s[rg][2 * kk][3]); w.z = cvt_pk_bf16(s[rg][2 * kk + 1][0], s[rg][2 * kk + 1][1]); w.w = cvt_pk_bf16(s[rg][2 * kk + 1][2], s[rg][2 * kk + 1][3]);
      pf[rg] = __builtin_bit_cast(bf16x8, w); }
#pragma unroll
    for (int dt = 0; dt < 4; ++dt) { LAS unsigned char* va = vt_ + (32 * kk + 4 * fq + tq) * 144 + (16 * dt + 4 * tp) * 2; const bf16x8 vf = tr_read8(va, va + 16 * 144);
      ot[0][dt] = MFMA16(vf, pf[0], ot[0][dt]); ot[1][dt] = MFMA16(vf, pf[1], ot[1][dt]); }
    __builtin_amdgcn_sched_barrier(0);
  }
  __builtin_amdgcn_s_setprio(0);
}

__device__ __forceinline__ void attn_phase(LAS unsigned char* lds, const bf16_t* Qb, const bf16_t* KV, const float* gates, const bf16_t* KC, bf16_t* ATT) {
  int tid_ = threadIdx.x; asm volatile("" : "+v"(tid_));
  const int tid = tid_, wave = __builtin_amdgcn_readfirstlane(tid >> 6), lane = tid & 63, fr = lane & 15, fq = lane >> 4, tq = (lane & 15) >> 2, tp = lane & 3;
  const int G = gridDim.x;
  const int lkey = tid >> 3, lc16 = tid & 7;
  const bool xcd_order = (G == 256);
  for (int it = 0; it < (xcd_order ? 8 : (2048 + G - 1) / G); ++it) {
    int bg, tile;
    if (xcd_order) { const int x = blockIdx.x & 7, slot = blockIdx.x >> 3; bg = 8 * (it >> 1) + x; tile = (it & 1) ? 63 - slot : slot; }
    else { const int id = it * G + (int)blockIdx.x; if (id >= 2048) break; bg = id >> 6; tile = ((id & 63) + 8 * (id >> 8)) & 63; }
    const int b = bg >> 2, g = bg & 3, q0 = tile * 64, cur = tile;
    const int head = fr & 3;
    int t[2]; size_t grow[2]; bf16x8 qf[2][2]; float g_cmp[2], g_slc[2], g_win[2];
#pragma unroll
    for (int rg = 0; rg < 2; ++rg) { t[rg] = q0 + 32 * rg + 4 * wave + (fr >> 2); grow[rg] = (size_t)b * SEQ + t[rg];
#pragma unroll
      for (int ks = 0; ks < 2; ++ks) { const u32x4 qraw = *(const u32x4*)(Qb + grow[rg] * 1024 + (g * 4 + head) * 64 + 32 * ks + 8 * fq); u32x4 qs;
#pragma unroll
        for (int e = 0; e < 4; ++e) qs[e] = cvt_pk_bf16(__uint_as_float(qraw[e] << 16) * 0.18033688011112042f, __uint_as_float(qraw[e] & 0xffff0000u) * 0.18033688011112042f);
        qf[rg][ks] = __builtin_bit_cast(bf16x8, qs); }
      const float* gp = gates + grow[rg] * 48 + (g * 4 + head) * 3; g_cmp[rg] = gp[0]; g_slc[rg] = gp[1]; g_win[rg] = gp[2]; }
    const int kbmax = ((q0 + 32) >> 10) < 3 ? ((q0 + 32) >> 10) : 3;
    { const bf16_t* kc = KC + (size_t)(b * 4 + g) * 256 * 64; const bf16_t* vc = kc + (size_t)8 * 4 * 256 * 64;
#pragma unroll
      for (int i = 0; i < 4; ++i) { const int pp = tid + 512 * i, key = pp >> 3, c16 = pp & 7;
        *(LAS u32x4*)(lds + AT_KC + key * 144 + c16 * 16) = *(const u32x4*)(kc + key * 64 + c16 * 8);
        *(LAS u32x4*)(lds + AT_VC + key * 144 + c16 * 16) = *(const u32x4*)(vc + key * 64 + c16 * 8); } }
    if (kbmax < 3) {
#pragma unroll
      for (int i = 0; i < 4; ++i) *(LAS u32x4*)(lds + AT_PS + (tid + 512 * i) * 16) = (u32x4){0u, 0u, 0u, 0u};
    }
    __syncthreads();
    unsigned long long selmask[2];
#pragma unroll
    for (int rg = 0; rg < 2; ++rg) {
      const int tokl = 4 * wave + (fr >> 2), tt = t[rg];
      float mx = -1e30f, ls = 0.f;
#pragma unroll 1
      for (int kb = 0; kb <= kbmax; ++kb) {
        float bm = -1e30f; f32x4 s[4];
#pragma unroll
        for (int kt = 0; kt < 4; ++kt) { f32x4 a = {0.f, 0.f, 0.f, 0.f};
#pragma unroll
          for (int ks = 0; ks < 2; ++ks) { const bf16x8 kf = *(const LAS bf16x8*)(lds + AT_KC + (64 * kb + 16 * kt + fr) * 144 + (32 * ks + 8 * fq) * 2); a = MFMA16(kf, qf[rg][ks], a); }
#pragma unroll
          for (int r = 0; r < 4; ++r) { const int key = 64 * kb + 16 * kt + 4 * fq + r; const float sv = (16 * key + 31 <= tt) ? a[r] : -1e30f; a[r] = sv; bm = fmaxf(bm, sv); }
          s[kt] = a; }
        bm = fmaxf(bm, __shfl_xor(bm, 16)); bm = fmaxf(bm, __shfl_xor(bm, 32));
        const float mnew = fmaxf(mx, bm); float bs = 0.f;
#pragma unroll
        for (int kt = 0; kt < 4; ++kt)
#pragma unroll
          for (int r = 0; r < 4; ++r) { const int key = 64 * kb + 16 * kt + 4 * fq + r; bs += (16 * key + 31 <= tt) ? __builtin_amdgcn_exp2f(s[kt][r] - mnew) : 0.f; }
        ls = ls * __builtin_amdgcn_exp2f(mx - mnew) + bs; mx = mnew;
      }
      ls += __shfl_xor(ls, 16); ls += __shfl_xor(ls, 32);
      const float inv = (tt >= 31) ? 1.0f / ls : 0.f;
      f32x4 ot[4];
#pragma unroll
      for (int dt = 0; dt < 4; ++dt) ot[dt] = (f32x4){0.f, 0.f, 0.f, 0.f};
#pragma unroll 1
      for (int kb = 0; kb <= kbmax; ++kb) {
        f32x4 s[4];
#pragma unroll
        for (int kt = 0; kt < 4; ++kt) { f32x4 a = {0.f, 0.f, 0.f, 0.f};
#pragma unroll
          for (int ks = 0; ks < 2; ++ks) { const bf16x8 kf = *(const LAS bf16x8*)(lds + AT_KC + (64 * kb + 16 * kt + fr) * 144 + (32 * ks + 8 * fq) * 2); a = MFMA16(kf, qf[rg][ks], a); }
#pragma unroll
          for (int r = 0; r < 4; ++r) { const int key = 64 * kb + 16 * kt + 4 * fq + r; a[r] = (16 * key + 31 <= tt) ? __builtin_amdgcn_exp2f(a[r] - mx) * inv : 0.f; }
          s[kt] = a;
          f32x4 hs = a;
#pragma unroll
          for (int r = 0; r < 4; ++r) { hs[r] += __shfl_xor(hs[r], 1); hs[r] += __shfl_xor(hs[r], 2); }
          if (head == 0) *(LAS f32x4*)(lds + AT_PS + (tokl * 256 + 64 * kb + 16 * kt + 4 * fq) * 4) = hs; }
#pragma unroll
        for (int kk = 0; kk < 2; ++kk) {
          u32x4 w; w.x = cvt_pk_bf16(s[2 * kk][0], s[2 * kk][1]); w.y = cvt_pk_bf16(s[2 * kk][2], s[2 * kk][3]); w.z = cvt_pk_bf16(s[2 * kk + 1][0], s[2 * kk + 1][1]); w.w = cvt_pk_bf16(s[2 * kk + 1][2], s[2 * kk + 1][3]);
          const bf16x8 pf = __builtin_bit_cast(bf16x8, w);
#pragma unroll
          for (int dt = 0; dt < 4; ++dt) { LAS unsigned char* va = lds + AT_VC + (64 * kb + 32 * kk + 4 * fq + tq) * 144 + (16 * dt + 4 * tp) * 2; const bf16x8 vf = tr_read8(va, va + 16 * 144); ot[dt] = MFMA16(vf, pf, ot[dt]); }
        }
      }
#pragma unroll
      for (int dt = 0; dt < 4; ++dt) { const f32x4 o = ot[dt] * g_cmp[rg]; u32x2 w; w.x = cvt_pk_bf16(o[0], o[1]); w.y = cvt_pk_bf16(o[2], o[3]); *(LAS u32x2*)(lds + AT_PARK + tid * 64 + (rg * 4 + dt) * 8) = w; }
      __syncthreads();
      const int tk = lane >> 4;
      float val[4];
#pragma unroll
      for (int i = 0; i < 4; ++i) { const int n = (lane & 15) + 16 * i; float imp = 0.f;
#pragma unroll
        for (int k = -1; k < 4; ++k) { const int key = 4 * n + k; if (key >= 0) imp += *(const LAS float*)(lds + AT_PS + ((4 * wave + tk) * 256 + key) * 4); }
        const bool fut = n > cur, forced = (n == 0) || (n == cur) || (n == cur - 1);
        val[i] = fut ? -1e30f : (forced ? imp + 1e4f : imp);
        *(LAS float*)(lds + AT_VALS + ((4 * wave + tk) * 64 + n) * 4) = val[i]; }
      __syncthreads();
      int rank[4] = {0, 0, 0, 0};
      for (int n2 = 0; n2 < 64; ++n2) { const float v2 = *(const LAS float*)(lds + AT_VALS + ((4 * wave + tk) * 64 + n2) * 4);
#pragma unroll
        for (int i = 0; i < 4; ++i) { const int n = (lane & 15) + 16 * i; rank[i] += (v2 > val[i] || (v2 == val[i] && n2 < n)) ? 1 : 0; } }
      unsigned long long m = 0ull;
#pragma unroll
      for (int i = 0; i < 4; ++i) { const unsigned long long bal = __ballot(rank[i] < 16); m |= ((bal >> (16 * (fr >> 2))) & 0xffffull) << (16 * i); }
      selmask[rg] = m;
      __syncthreads();
    }
#pragma unroll 1
    for (int br = 0; br < 2; ++br) {
      const bf16_t* Kg = KV + (size_t)(br == 0 ? 2 : 4) * ((size_t)MT * 256) + (size_t)b * SEQ * 256 + g * 64; const bf16_t* Vg = Kg + (size_t)MT * 256;
      const int nlo = (br == 0) ? 0 : ((q0 - 511) > 0 ? ((q0 - 511) >> 6) : 0), nhi = cur;
      f32x4 ot[2][4];
#pragma unroll
      for (int rg = 0; rg < 2; ++rg)
#pragma unroll
        for (int dt = 0; dt < 4; ++dt) ot[rg][dt] = (f32x4){0.f, 0.f, 0.f, 0.f};
      float mrun[2] = {-1e30f, -1e30f}, lrun[2] = {0.f, 0.f};
      u32x4 kr[2], vr[2];
#pragma unroll
      for (int u = 0; u < 2; ++u) if (nlo + u <= nhi) { kr[u] = *(const u32x4*)(Kg + (size_t)((nlo + u) * 64 + lkey) * 256 + lc16 * 8); vr[u] = *(const u32x4*)(Vg + (size_t)((nlo + u) * 64 + lkey) * 256 + lc16 * 8); }
      for (int nb = nlo; nb <= nhi; nb += 2) {
        const int sb = ((nb - nlo) >> 1) & 1;
#pragma unroll
        for (int u = 0; u < 2; ++u) if (nb + u <= nhi) { LAS unsigned char* kb_ = lds + (2 * sb + u) * 18432;
          *(LAS u32x4*)(kb_ + lkey * 144 + lc16 * 16) = kr[u]; *(LAS u32x4*)(kb_ + 9216 + lkey * 144 + lc16 * 16) = vr[u]; }
        __syncthreads();
#pragma unroll
        for (int u = 0; u < 2; ++u) if (nb + 2 + u <= nhi) { kr[u] = *(const u32x4*)(Kg + (size_t)((nb + 2 + u) * 64 + lkey) * 256 + lc16 * 8); vr[u] = *(const u32x4*)(Vg + (size_t)((nb + 2 + u) * 64 + lkey) * 256 + lc16 * 8); }
#pragma unroll
        for (int u = 0; u < 2; ++u) {
          const int n = nb + u;
          if (n <= nhi) {
            LAS unsigned char* kb_ = lds + (2 * sb + u) * 18432; LAS unsigned char* vb_ = kb_ + 9216;
            const bool need = (br == 1) || (__ballot((((selmask[0] | selmask[1]) >> n) & 1ull) != 0ull) != 0ull);
            if (need) {
              const bool interior = (br == 0) ? (n < cur) : ((64 * n + 63 <= q0) && (64 * n > q0 + 63 - 512));
              if (!interior) flash_block2<0>(kb_, vb_, qf, ot, mrun, lrun, fr, fq, tq, tp, br, n * 64, t, selmask, n);
              else if (br == 0) flash_block2<1>(kb_, vb_, qf, ot, mrun, lrun, fr, fq, tq, tp, br, n * 64, t, selmask, n);
              else flash_block2<2>(kb_, vb_, qf, ot, mrun, lrun, fr, fq, tq, tp, br, n * 64, t, selmask, n);
            }
          }
        }
      }
      __syncthreads();
#pragma unroll
      for (int rg = 0; rg < 2; ++rg) {
        float lt = lrun[rg]; lt += __shfl_xor(lt, 16); lt += __shfl_xor(lt, 32);
        const float sc_ = (lt > 0.f) ? ((br == 0 ? g_slc[rg] : g_win[rg]) / lt) : 0.f;
#pragma unroll
        for (int dt = 0; dt < 4; ++dt) { const u32x2 p0 = *(const LAS u32x2*)(lds + AT_PARK + tid * 64 + (rg * 4 + dt) * 8); const f32x4 o = ot[rg][dt] * sc_; u32x2 w;
          w.x = cvt_pk_bf16(__uint_as_float(p0.x << 16) + o[0], __uint_as_float(p0.x & 0xffff0000u) + o[1]); w.y = cvt_pk_bf16(__uint_as_float(p0.y << 16) + o[2], __uint_as_float(p0.y & 0xffff0000u) + o[3]);
          if (br == 0) *(LAS u32x2*)(lds + AT_PARK + tid * 64 + (rg * 4 + dt) * 8) = w;
          else *(u32x2*)(ATT + grow[rg] * 1024 + (g * 4 + head) * 64 + 16 * dt + 4 * fq) = w; }
      }
    }
    __syncthreads();
  }
}

constexpr size_t WS_BAR = 490 * MiB;
struct FastBar { unsigned* bar; unsigned xcc, nloc, nx; };
__device__ __forceinline__ unsigned xcc_id() { return (unsigned)__builtin_amdgcn_s_getreg((3 << 11) | 20) & 0xFu; }
__device__ __forceinline__ void fast_barrier(const FastBar& fb, const unsigned target) {
  asm volatile("s_waitcnt vmcnt(0)" ::: "memory");
  __syncthreads();
  if (threadIdx.x == 0) {
    const unsigned old = __hip_atomic_fetch_add(fb.bar + 64 * fb.xcc, 1u, __ATOMIC_RELAXED, __HIP_MEMORY_SCOPE_AGENT);
    if (old + 1u == target * fb.nloc) {
      __builtin_amdgcn_fence(__ATOMIC_RELEASE, "agent");
      const unsigned t = __hip_atomic_fetch_add(fb.bar + 64 * 32, 1u, __ATOMIC_RELAXED, __HIP_MEMORY_SCOPE_AGENT);
      if (t + 1u == target * fb.nx) __hip_atomic_store(fb.bar + 64 * 33, target, __ATOMIC_RELAXED, __HIP_MEMORY_SCOPE_AGENT);
    }
    while (__hip_atomic_load(fb.bar + 64 * 33, __ATOMIC_RELAXED, __HIP_MEMORY_SCOPE_AGENT) < target) __builtin_amdgcn_s_sleep(1);
    __builtin_amdgcn_fence(__ATOMIC_ACQUIRE, "agent");
    asm volatile("s_waitcnt vmcnt(0)" ::: "memory");
  }
  __syncthreads();
}
enum { K_RETIN = 0, K_RETOUT = 1, K_NSAIN = 2, K_CMP1 = 3, K_NSAOUT = 4, K_GU = 5, K_DOWN = 6, K_SCAN = 7, K_GATE = 8, K_CMP2 = 9, K_ATTN = 10, K_NORMFFN = 11, K_NORMNEXT = 12 };

__global__ void __launch_bounds__(512, 2) mega_fwd(Params p_unused) {
  extern __shared__ __attribute__((aligned(16))) unsigned char lds_raw[];
  LAS unsigned char* lds = (LAS unsigned char*)lds_raw;
  cg::grid_group grid = cg::this_grid();
  FastBar fb; fb.bar = (unsigned*)(get_params()->ws + WS_BAR); fb.xcc = xcc_id();
  if (threadIdx.x == 0) __hip_atomic_fetch_add(fb.bar + 64 * (16 + fb.xcc), 1u, __ATOMIC_RELAXED, __HIP_MEMORY_SCOPE_AGENT);
  conv_mix((LAS float*)lds, 0);
  { KParams kp = get_params(); norm_phase(kp->x, kp->norm_mix, (bf16_t*)(kp->ws + WS_HN), nullptr); }
  grid.sync();
  { unsigned nx = 0u, nloc = 0u;
    for (unsigned j = 0; j < 16u; ++j) { const unsigned c = __hip_atomic_load(fb.bar + 64 * (16 + j), __ATOMIC_RELAXED, __HIP_MEMORY_SCOPE_AGENT); nx += (c > 0u) ? 1u : 0u; nloc = (j == fb.xcc) ? c : nloc; }
    fb.nx = (unsigned)__builtin_amdgcn_readfirstlane((int)nx); fb.nloc = (unsigned)__builtin_amdgcn_readfirstlane((int)nloc); }
#pragma unroll 1
  for (int layer = 0; layer < 4; ++layer) {
#pragma unroll 1
    for (int s = 0; s < 9; ++s) {
      const bool nsa = (layer & 1) != 0;
      const unsigned long long prog = nsa ? 0xFC65B4A32ull : 0xFC65B1870ull;
      const int kind = (int)((prog >> (4 * s)) & 0xFull);
      if (kind == 15) continue;
      KParams kp = get_params();
      unsigned char* ws = kp->ws; unsigned char* R = ws + WS_R; bf16_t* HN = (bf16_t*)(ws + WS_HN);
      if (kind <= K_DOWN) {
        pg8::GemmD g; pg8::EpiD E;
        E.kind = pg8::EK_RES; E.layer = layer;
        g.amode = 0; g.smode = 0; g.nM = 128;
        if (kind == K_RETIN) { g.A = HN; g.Bt = (const bf16_t*)(ws + WS_WMIX); g.K = 1024; g.nN = 24; E.kind = pg8::EK_RETIN; }
        else if (kind == K_RETOUT) { g.A = (const bf16_t*)(R + R_V); g.Bt = (const bf16_t*)(ws + WS_WMIX + 12 * MiB); g.K = 2048; g.nN = 4; if (layer == 0) E.layer = -1; }
        else if (kind == K_NSAIN) { g.A = HN; g.Bt = (const bf16_t*)(ws + WS_WMIX); g.K = 1024; g.nN = 11; E.kind = pg8::EK_NSAIN; }
        else if (kind == K_CMP1) { g.A = (const bf16_t*)(R + N_KV); g.Bt = (const bf16_t*)(ws + WS_WMIX + 8 * MiB); g.K = 2048; g.amode = 1; g.smode = 1; g.nM = 64; g.nN = 1; E.kind = pg8::EK_CMP1; }
        else if (kind == K_NSAOUT) { g.A = (const bf16_t*)(R + N_ATT); g.Bt = (const bf16_t*)(ws + WS_WMIX + 6 * MiB); g.K = 1024; g.nN = 4; }
        else if (kind == K_GU) { g.A = HN; g.Bt = (const bf16_t*)(ws + WS_WFFN); g.K = 1024; g.nN = 22; E.kind = pg8::EK_SWIGLU; }
        else { g.A = (const bf16_t*)R; g.Bt = (const bf16_t*)(ws + WS_WFFN + 11 * MiB); g.K = 2816; g.nN = 4; }
#if PROBE_DUP == 3
        if (kind == K_GU) pg8::gemm_phase(lds, g, E, (int)gridDim.x, (int)blockIdx.x);
#endif
#if PROBE_DUP == 7
        if (kind == K_CMP1) pg8::gemm_phase(lds, g, E, (int)gridDim.x, (int)blockIdx.x);
#endif
#if PROBE_DUP == 8
        if (kind == K_RETIN) pg8::gemm_phase(lds, g, E, (int)gridDim.x, (int)blockIdx.x);
#endif
        pg8::gemm_phase(lds, g, E, (int)gridDim.x, (int)blockIdx.x);
        if (kind == K_CMP1) {
          const int Gx = (int)gridDim.x, bx = (int)blockIdx.x; const bool split = Gx > 64;
          if (!split || bx >= 64) conv_ffn((LAS float*)lds, layer, split ? bx - 64 : bx, split ? Gx - 64 : Gx);
          if (!split || bx < 64) {
            __builtin_amdgcn_fence(__ATOMIC_SEQ_CST, "workgroup"); __syncthreads();
            for (int u = bx; u < 64; u += Gx) cmp2_phase((const bf16_t*)(R + N_HID), (const bf16_t*)(ws + WS_WMIX + 10 * MiB), (bf16_t*)(R + N_KC), u * 16);
          }
        }
      } else if (kind == K_SCAN) {
        scan_phase(lds, (const bf16_t*)(R + R_Q), (const bf16_t*)(R + R_K), (bf16_t*)(R + R_V), (float*)(ws + WS_SSQ));
      } else if (kind == K_GATE) {
        conv_ffn((LAS float*)lds, layer);
        gate_phase((bf16_t*)(R + R_V), (const bf16_t*)(R + R_G), (const float*)(ws + WS_SSQ));
#if PROBE_DUP == 6
        conv_ffn((LAS float*)lds, layer);
#endif
      } else if (kind == K_ATTN) {
#if PROBE_DUP == 1
        attn_phase(lds, (const bf16_t*)(R + N_Q), (const bf16_t*)(R + N_KV), (const float*)(R + N_GATES), (const bf16_t*)(R + N_KC), (bf16_t*)(R + N_ATT));
#endif
        attn_phase(lds, (const bf16_t*)(R + N_Q), (const bf16_t*)(R + N_KV), (const float*)(R + N_GATES), (const bf16_t*)(R + N_KC), (bf16_t*)(R + N_ATT));
      } else if (kind == K_NORMFFN) {
        norm_phase(kp->out, kp->norm_ffn + layer * 1024, HN, nullptr);
#if PROBE_DUP == 5
        norm_phase(kp->out, kp->norm_ffn + layer * 1024, HN, nullptr);
#endif
      } else {
        if (layer < 3) { conv_mix((LAS float*)lds, layer + 1); KParams k2 = get_params(); norm_phase(k2->out, k2->norm_mix + (layer + 1) * 1024, (bf16_t*)(k2->ws + WS_HN), nullptr); }
        else norm_phase(kp->out, kp->norm_final, nullptr, kp->out);
      }
      fb.bar = (unsigned*)(get_params()->ws + WS_BAR);
      fast_barrier(fb, (unsigned)__builtin_amdgcn_readfirstlane(layer * 8 + s + 1));
    }
  }
}

extern "C" void kernel_launch(void* const* d_in, const int* in_sizes, int n_in, void* d_out, int out_size, void* d_ws, size_t ws_size, hipStream_t stream) {
  static int grid_blocks = 0;
  if (!grid_blocks) {
    int dev = 0, cus = 0, per_cu = 0;
    hipGetDevice(&dev);
    hipDeviceGetAttribute(&cus, hipDeviceAttributeMultiprocessorCount, dev);
    hipFuncSetAttribute((const void*)mega_fwd, hipFuncAttributeMaxDynamicSharedMemorySize, LDS_BYTES);
    hipOccupancyMaxActiveBlocksPerMultiprocessor(&per_cu, (const void*)mega_fwd, 512, LDS_BYTES);
    if (per_cu < 1) per_cu = 1;
    grid_blocks = cus * 1;
    if (ws_size < 489 * MiB) fprintf(stderr, "kernel_launch: workspace too small: %zu\n", ws_size);
  }
  Params p{};
  p.x = (const float*)d_in[0]; p.pos = (const int*)d_in[1]; p.norm_mix = (const float*)d_in[2]; p.norm_ffn = (const float*)d_in[3]; p.norm_final = (const float*)d_in[4];
  p.ret_w_in = (const float*)d_in[5]; p.ret_w_out = (const float*)d_in[6]; p.nsa_w_in = (const float*)d_in[7]; p.cmp_pos = (const float*)d_in[8]; p.cmp_w1 = (const float*)d_in[9];
  p.cmp_w2 = (const float*)d_in[10]; p.nsa_w_out = (const float*)d_in[11]; p.ffn_w_gu = (const float*)d_in[12]; p.ffn_w_down = (const float*)d_in[13];
  p.out = (float*)d_out; p.ws = (unsigned char*)d_ws;
  (void)hipMemsetAsync((char*)d_ws + WS_BAR, 0, 64 * 4 * 34, stream);
  void* args[] = {&p};
  hipError_t e = hipLaunchCooperativeKernel((const void*)mega_fwd, dim3(grid_blocks), dim3(512), args, LDS_BYTES, stream);
  if (e != hipSuccess) fprintf(stderr, "cooperative launch failed: %s (grid %d)\n", hipGetErrorString(e), grid_blocks);
}
```
